# Optimizing an MI355X kernel written in HIP

```python
import math
import jax, jax.numpy as jnp
from jax import lax
import numpy as np

D_MODEL = 1024
BATCH = 16
SEQ = 4096
DEPTH = 2
DEC_BATCH = 8
DEC_SEQ = 32
PAST_LEN = 1024

CHUNK = 64
N_META = 16
N_A_LAYERS = max(1, DEPTH // 2)
N_B_LAYERS = DEPTH - N_A_LAYERS
D_RNN = 1280
N_RNN_BLOCKS = 10
RNN_BLOCK = D_RNN // N_RNN_BLOCKS
CONV_W = 4
LRU_C = 8.0
D_FF = 4 * D_MODEL
N_HEADS = 8
HD = 64
VD = 2 * HD
N_BUCKETS = 32
MAX_DIST = 128
Q_BLOCK = 128
EPS = 1e-6
NEG = -1e30

kernel_name = 'yoco_rglru_diffattn_stream_step'


def rmsnorm(x, g):
    xf = x.astype(jnp.float32)
    y = xf * lax.rsqrt(jnp.mean(xf * xf, axis=-1, keepdims=True) + EPS)
    return (y * g.astype(jnp.float32)).astype(x.dtype)


def sq_relu_mlp(x, w_up, w_down):
    h = jax.nn.relu(x @ w_up)
    return (h * h) @ w_down


def causal_conv(x, buf, w, b):
    t = x.shape[1]
    xp = jnp.concatenate([buf.astype(x.dtype), x], axis=1)
    y = xp[:, 0:t] * w[0]
    for j in range(1, CONV_W):
        y = y + xp[:, j:j + t] * w[j]
    return y + b, xp[:, -(CONV_W - 1):]


def rg_lru(x, h0, w_r, b_r, w_i, b_i, lam):
    bsz, t, _ = x.shape
    xb = x.reshape(bsz, t, N_RNN_BLOCKS, RNN_BLOCK)
    r = jax.nn.sigmoid(jnp.einsum('btni,nij->btnj', xb, w_r).reshape(bsz, t, D_RNN) + b_r).astype(jnp.float32)
    i = jax.nn.sigmoid(jnp.einsum('btni,nij->btnj', xb, w_i).reshape(bsz, t, D_RNN) + b_i).astype(jnp.float32)
    log_a = -LRU_C * r * jax.nn.softplus(-lam.astype(jnp.float32))
    a = jnp.exp(log_a)
    u = jnp.sqrt(-jnp.expm1(2.0 * log_a)) * (i * x.astype(jnp.float32))

    def combine(e1, e2):
        a1, b1 = e1
        a2, b2 = e2
        return a1 * a2, a2 * b1 + b2

    a_cum, hs = lax.associative_scan(combine, (a, u), axis=1)
    hs = hs + a_cum * h0.astype(jnp.float32)[:, None, :]
    return hs.astype(x.dtype), hs[:, -1].astype(x.dtype)


def recurrent_block(x, h0, conv_buf, w_in, conv_w, conv_b, w_r, b_r, w_i, b_i, lam, w_out):
    gx = x @ w_in
    gate, xr = gx[..., :D_RNN], gx[..., D_RNN:]
    xc, new_buf = causal_conv(xr, conv_buf, conv_w, conv_b)
    hs, h_last = rg_lru(xc, h0, w_r, b_r, w_i, b_i, lam)
    return (jax.nn.gelu(gate) * hs) @ w_out, h_last, new_buf


def t5_bucket(rel):
    nb = N_BUCKETS // 2
    max_exact = nb // 2
    ret = jnp.where(rel > 0, nb, 0)
    n = jnp.abs(rel)
    nf = jnp.maximum(n, 1).astype(jnp.float32)
    large = max_exact + (jnp.log(nf / max_exact) / math.log(MAX_DIST / max_exact) * (nb - max_exact)).astype(jnp.int32)
    large = jnp.minimum(large, nb - 1)
    return ret + jnp.where(n < max_exact, n, large)


def diff_attend(q, k, v, q_pos, k_pos, lam, rel_bias):
    s = jnp.einsum('bqhmd,bkhmd->bmhqk', q, k, preferred_element_type=jnp.float32) * (HD ** -0.5)
    bias = jnp.transpose(rel_bias.astype(jnp.float32)[t5_bucket(k_pos[None, :] - q_pos[:, None])], (2, 0, 1))
    visible = (k_pos[None, :] // CHUNK) <= (q_pos[:, None] // CHUNK)
    s = jnp.where(visible, s + bias, NEG)
    p = jax.nn.softmax(s, axis=-1)
    w = p[:, 0] - lam * p[:, 1]
    return jnp.einsum('bhqk,bkhd->bqhd', w.astype(v.dtype), v)


def diff_lambda(lq1, lk1, lq2, lk2, lam_init):
    f = jnp.float32
    return jnp.exp(jnp.sum(lq1.astype(f) * lk1.astype(f))) - jnp.exp(jnp.sum(lq2.astype(f) * lk2.astype(f))) + lam_init


def shared_kv(h, g, w_kv):
    bsz, t = h.shape[:2]
    kv = rmsnorm(h, g) @ w_kv
    k = kv[..., :N_HEADS * VD].reshape(bsz, t, N_HEADS, VD)
    v = kv[..., N_HEADS * VD:].reshape(bsz, t, N_HEADS, VD)
    return k, v


def trunk(h, h0, conv0, n_lead, make_attend, P):
    new_h, new_conv = [], []
    attend = None
    k = v = None
    for layer in range(DEPTH):
        if layer < N_A_LAYERS:
            a = layer
            y, h_last, buf = recurrent_block(
                rmsnorm(h, P['norm_mix_g'][layer]), h0[a], conv0[a],
                P['w_in_a'][a], P['conv_w'][a], P['conv_b'][a], P['w_gate_r'][a], P['b_gate_r'][a],
                P['w_gate_i'][a], P['b_gate_i'][a], P['lru_lambda'][a], P['w_out_a'][a])
            new_h.append(h_last)
            new_conv.append(buf)
        else:
            b = layer - N_A_LAYERS
            lam_init = 0.8 - 0.6 * math.exp(-0.3 * layer)
            lam = diff_lambda(P['lambda_q1'][b], P['lambda_k1'][b], P['lambda_q2'][b], P['lambda_k2'][b], lam_init)
            bsz, t = h.shape[:2]
            q = (rmsnorm(h, P['norm_mix_g'][layer]) @ P['w_q'][b]).reshape(bsz, t, N_HEADS, 2, HD)
            o = attend(q, lam)
            o = rmsnorm(o, P['subln_g'][b]) * (1.0 - lam_init)
            y = o.reshape(bsz, t, N_HEADS * VD) @ P['w_o'][b]
        h = h + y
        h = h + sq_relu_mlp(rmsnorm(h, P['norm_mlp_g'][layer]), P['w_mlp_up'][layer], P['w_mlp_down'][layer])
        if layer == N_A_LAYERS - 1:
            k, v = shared_kv(h, P['norm_kv_g'], P['w_kv'])
            attend = make_attend(k, v)
            h = h[:, n_lead:]
    return rmsnorm(h, P['norm_f_g']), jnp.stack(new_h), jnp.stack(new_conv), k, v


def setup_inputs(seed: int = 0) -> dict:
    key = jax.random.key(seed)
    ks = iter(jax.random.split(key, 48))

    def nrm(shape, scale):
        return scale * jax.random.normal(next(ks), shape, jnp.float32)

    def gain(shape):
        return 1.0 + nrm(shape, 0.02)

    NA, NB = N_A_LAYERS, N_B_LAYERS
    u = jax.random.uniform(next(ks), (NA, D_RNN), jnp.float32, 0.9, 0.999)
    s = u ** (1.0 / LRU_C)
    lru_lambda = jnp.log(s) - jnp.log1p(-s)
    return {
        'x_prompt': nrm((BATCH, SEQ, D_MODEL), 1.0),
        'x_sample': nrm((DEC_BATCH, DEC_SEQ, D_MODEL), 1.0),
        'state_h': nrm((NA, DEC_BATCH, D_RNN), 0.5),
        'state_conv': nrm((NA, DEC_BATCH, CONV_W - 1, D_RNN), 1.0),
        'cache_meta_k': nrm((DEC_BATCH, N_META, N_HEADS, VD), 1.0),
        'cache_meta_v': nrm((DEC_BATCH, N_META, N_HEADS, VD), 1.0),
        'cache_k': nrm((DEC_BATCH, PAST_LEN, N_HEADS, VD), 1.0),
        'cache_v': nrm((DEC_BATCH, PAST_LEN, N_HEADS, VD), 1.0),
        'meta_tokens': nrm((N_META, D_MODEL), 1.0),
        'norm_mix_g': gain((DEPTH, D_MODEL)),
        'norm_mlp_g': gain((DEPTH, D_MODEL)),
        'w_mlp_up': nrm((DEPTH, D_MODEL, D_FF), D_MODEL ** -0.5),
        'w_mlp_down': nrm((DEPTH, D_FF, D_MODEL), D_FF ** -0.5),
        'w_in_a': nrm((NA, D_MODEL, 2 * D_RNN), D_MODEL ** -0.5),
        'conv_w': nrm((NA, CONV_W, D_RNN), CONV_W ** -0.5),
        'conv_b': nrm((NA, D_RNN), 0.02),
        'w_gate_r': nrm((NA, N_RNN_BLOCKS, RNN_BLOCK, RNN_BLOCK), RNN_BLOCK ** -0.5),
        'b_gate_r': nrm((NA, D_RNN), 0.02),
        'w_gate_i': nrm((NA, N_RNN_BLOCKS, RNN_BLOCK, RNN_BLOCK), RNN_BLOCK ** -0.5),
        'b_gate_i': nrm((NA, D_RNN), 0.02),
        'lru_lambda': lru_lambda,
        'w_out_a': nrm((NA, D_RNN, D_MODEL), D_RNN ** -0.5),
        'norm_kv_g': gain((D_MODEL,)),
        'w_kv': nrm((D_MODEL, 2 * N_HEADS * VD), D_MODEL ** -0.5),
        'w_q': nrm((NB, D_MODEL, N_HEADS * VD), D_MODEL ** -0.5),
        'lambda_q1': nrm((NB, HD), 0.1),
        'lambda_k1': nrm((NB, HD), 0.1),
        'lambda_q2': nrm((NB, HD), 0.1),
        'lambda_k2': nrm((NB, HD), 0.1),
        'subln_g': gain((NB, VD)),
        'w_o': nrm((NB, N_HEADS * VD, D_MODEL), (N_HEADS * VD) ** -0.5),
        'rel_bias': nrm((N_BUCKETS, N_HEADS), 0.5),
        'norm_f_g': gain((D_MODEL,)),
    }


def reference(x_prompt, x_sample, state_h, state_conv, cache_meta_k, cache_meta_v, cache_k, cache_v,
              meta_tokens, norm_mix_g, norm_mlp_g, w_mlp_up, w_mlp_down, w_in_a, conv_w, conv_b,
              w_gate_r, b_gate_r, w_gate_i, b_gate_i, lru_lambda, w_out_a, norm_kv_g, w_kv, w_q,
              lambda_q1, lambda_k1, lambda_q2, lambda_k2, subln_g, w_o, rel_bias, norm_f_g):
    P = {
        'norm_mix_g': norm_mix_g, 'norm_mlp_g': norm_mlp_g, 'w_mlp_up': w_mlp_up, 'w_mlp_down': w_mlp_down,
        'w_in_a': w_in_a, 'conv_w': conv_w, 'conv_b': conv_b, 'w_gate_r': w_gate_r, 'b_gate_r': b_gate_r,
        'w_gate_i': w_gate_i, 'b_gate_i': b_gate_i, 'lru_lambda': lru_lambda, 'w_out_a': w_out_a,
        'norm_kv_g': norm_kv_g, 'w_kv': w_kv, 'w_q': w_q, 'lambda_q1': lambda_q1, 'lambda_k1': lambda_k1,
        'lambda_q2': lambda_q2, 'lambda_k2': lambda_k2, 'subln_g': subln_g, 'w_o': w_o, 'norm_f_g': norm_f_g,
    }

    bp, tp, _ = x_prompt.shape
    meta = jnp.broadcast_to(meta_tokens.astype(x_prompt.dtype)[None], (bp, N_META, D_MODEL))
    hp = jnp.concatenate([meta, x_prompt], axis=1)
    h0_p = jnp.zeros((N_A_LAYERS, bp, D_RNN), x_prompt.dtype)
    conv0_p = jnp.zeros((N_A_LAYERS, bp, CONV_W - 1, D_RNN), x_prompt.dtype)
    n_blk = tp // Q_BLOCK
    k_pos_p = jnp.arange(-N_META, tp, dtype=jnp.int32)

    def prompt_make_attend(k, v):
        k5 = k.reshape(bp, N_META + tp, N_HEADS, 2, HD)

        def attend(q, lam):
            qb = jnp.moveaxis(q.reshape(bp, n_blk, Q_BLOCK, N_HEADS, 2, HD), 1, 0)

            def one(args):
                q_i, start = args
                q_pos = start + jnp.arange(Q_BLOCK, dtype=jnp.int32)
                return diff_attend(q_i, k5, v, q_pos, k_pos_p, lam, rel_bias)

            o = lax.map(one, (qb, jnp.arange(n_blk, dtype=jnp.int32) * Q_BLOCK))
            return jnp.moveaxis(o, 0, 1).reshape(bp, tp, N_HEADS, VD)
        return attend

    y_prompt, sh_p, sc_p, k_p, v_p = trunk(hp, h0_p, conv0_p, N_META, prompt_make_attend, P)

    bs, ts, _ = x_sample.shape
    past = cache_k.shape[1]
    k_pos_s = jnp.arange(-N_META, past + ts, dtype=jnp.int32)
    q_pos_s = past + jnp.arange(ts, dtype=jnp.int32)

    def sample_make_attend(k, v):
        k_all = jnp.concatenate([cache_meta_k.astype(k.dtype), cache_k.astype(k.dtype), k], axis=1)
        v_all = jnp.concatenate([cache_meta_v.astype(v.dtype), cache_v.astype(v.dtype), v], axis=1)
        k5 = k_all.reshape(bs, N_META + past + ts, N_HEADS, 2, HD)

        def attend(q, lam):
            return diff_attend(q, k5, v_all, q_pos_s, k_pos_s, lam, rel_bias)
        return attend

    y_sample, sh_s, sc_s, k_s, v_s = trunk(x_sample, state_h, state_conv, 0, sample_make_attend, P)

    return (y_prompt, y_sample, sh_p, sc_p, k_p[:, :N_META], v_p[:, :N_META], k_p[:, N_META:], v_p[:, N_META:],
            sh_s, sc_s, k_s, v_s)
```

```cpp
#include <hip/hip_runtime.h>
#include <hip/hip_cooperative_groups.h>
#include <cstdio>
#include <cstdint>
namespace cg = cooperative_groups;

constexpr int R_SAMP = 65536, R_META = 65792, R_PAD = 65808, MROWS = 66048, MROWS1 = 65792;
constexpr int R_HALO_S = 65808;
constexpr int R_HALO_Z = 65832;
constexpr int DM = 1024, DR = 1280, DFF = 4096;
constexpr size_t OFF_Y = 0, OFF_SHP = 67371008, OFF_SCP = 67391488, OFF_MK = 67452928, OFF_MV = 67715072, OFF_KP = 67977216,
                 OFF_VP = 135086080, OFF_SHS = 202194944, OFF_SCS = 202205184, OFF_KS = 202235904, OFF_VS = 202498048;
constexpr float EPS = 1e-6f, LOG2E = 1.4426950408889634f;
constexpr float LAM_INIT = 0.35550906759f;
constexpr float QSCALE = 0.125f * LOG2E;

__device__ __forceinline__ int otid() { int t = threadIdx.x; asm volatile("" : "+v"(t)); return t; }

namespace pg8 {
#define PG8_LAS __attribute__((address_space(3)))
typedef unsigned short bf16_t;
typedef short bf16x8 __attribute__((ext_vector_type(8)));
typedef float f32x4 __attribute__((ext_vector_type(4)));
typedef unsigned u32x4 __attribute__((ext_vector_type(4)));
constexpr int BM = 256, BK = 64, HALF = 128, HTB = HALF * BK * 2  , STAGE_BYTES = 8 * HTB, NXCD = 8, WGM = 8;

__host__ __device__ __forceinline__ int lds_byte(int r, int c) { const int st = (r >> 4) * 2 + (c >> 5), rr = r & 15, cc = c & 31, ob = rr * 64 + cc * 2; return st * 1024 + (ob ^ (((ob >> 9) & 1) << 5)); }
__host__ __device__ __forceinline__ void stage_rc(int b, int& R, int& C) { const int st = b / 1024, sb = b % 1024, swz = sb ^ (((sb >> 9) & 1) << 5); R = (st >> 1) * 16 + swz / 64; C = (st & 1) * 32 + (swz % 64) / 2; }
__host__ __device__ __forceinline__ int perm32(int rho) { const int n = rho >> 4, i = rho & 15; return 8 * (i >> 2) + 4 * n + (i & 3); }

struct Unit { int pm, pn, ko; };
struct Gemm { const bf16_t* A; const bf16_t* Bt; int M, N, K, ld; };

struct StaticOrder {
    int nM, nN, nwg, G, c;
    __host__ __device__ void init(int M, int N, int G_, int c_) { nM = M / BM; nN = N / BM; nwg = nM * nN; G = G_; c = c_; }
    __host__ __device__ bool next(int i, Unit& u) const {
        const long L = (long)i * G + c; if (L >= nwg) return false;
        int wgid = (int)L; { const int q = nwg / NXCD, r = nwg % NXCD, xcd = wgid % NXCD, off = wgid / NXCD; wgid = (xcd < r ? xcd * (q + 1) : r * (q + 1) + (xcd - r) * q) + off; }
        const int nig = WGM * nN, gid = wgid / nig, fm = gid * WGM, gsz = (nM - fm) < WGM ? (nM - fm) : WGM;
        u.pm = fm + ((wgid % nig) % gsz); u.pn = (wgid % nig) / gsz; u.ko = 0; return true;
    }
    __device__ __forceinline__ void a_ready(const Unit&) const {}
    __device__ __forceinline__ void done(const Unit&) const {}
};

__device__ __forceinline__ unsigned cvt_pk_bf16(float lo, float hi) { unsigned r; asm volatile("v_cvt_pk_bf16_f32 %0, %1, %2" : "=v"(r) : "v"(lo), "v"(hi)); return r; }
typedef float f32x2 __attribute__((ext_vector_type(2)));

__device__ __forceinline__ float bf_lo(unsigned w) { return __uint_as_float(w << 16); }
__device__ __forceinline__ float bf_hi(unsigned w) { return __uint_as_float(w & 0xffff0000u); }
__device__ __forceinline__ float gelu_tanh(float x) {
    const float u = 0.7978845608f * (x + 0.044715f * x * x * x);
    return x * __builtin_amdgcn_rcpf(1.f + __builtin_amdgcn_exp2f(-2.885390082f * u));
}
typedef float pk_f32x2 __attribute__((ext_vector_type(2))); typedef __bf16 pk_bf16x2 __attribute__((ext_vector_type(2)));
__device__ __forceinline__ unsigned pkbf(float lo, float hi) { pk_f32x2 v = {lo, hi}; pk_bf16x2 r = __builtin_convertvector(v, pk_bf16x2); return __builtin_bit_cast(unsigned, r); }
__device__ __forceinline__ u32x4 pack8(const f32x4 v0, const f32x4 v1) {
    u32x4 w; w.x = pkbf(v0[0], v0[1]); w.y = pkbf(v0[2], v0[3]); w.z = pkbf(v1[0], v1[1]); w.w = pkbf(v1[2], v1[3]); return w;
}
struct EpiIn {
    static constexpr bool PERM = true, AFTER_DRAIN = false;
    bf16_t* gate; bf16_t* xr; const float* rs; float* out;
    __device__ __forceinline__ void operator()(const f32x4 (&acc)[2][2][4][2], const Unit& u, int wr, int wc, int fr, int fq) const {
        const bool isgate = u.pn < 5;
        const int colt = (isgate ? u.pn : u.pn - 5) * BM + wc * 32 + 8 * fq;
        bf16_t* base = isgate ? gate : xr;
        float sc[2][4];
#pragma unroll
        for (int ai = 0; ai < 2; ++ai)
#pragma unroll
            for (int m = 0; m < 4; ++m) sc[ai][m] = rs[u.pm * BM + ai * HALF + wr * 64 + m * 16 + fr];
#pragma unroll
        for (int ai = 0; ai < 2; ++ai)
#pragma unroll
            for (int m = 0; m < 4; ++m) {
                const int row = u.pm * BM + ai * HALF + wr * 64 + m * 16 + fr;
                const float s = sc[ai][m];
                float* sdst = nullptr;
                if (!isgate) {
                    if (row < R_SAMP) { const int t = row & 4095; if (t >= 4093) sdst = out + OFF_SCP + (size_t)((row >> 12) * 3 + (t - 4093)) * DR; }
                    else if (row < R_META) { const int q = row - R_SAMP, t = q & 31; if (t >= 29) sdst = out + OFF_SCS + (size_t)((q >> 5) * 3 + (t - 29)) * DR; }
                }
                const bool ok = isgate || row < R_PAD;
#pragma unroll
                for (int bj = 0; bj < 2; ++bj) {
                    f32x4 v0 = acc[ai][bj][m][0] * s, v1 = acc[ai][bj][m][1] * s;
                    const int col = colt + bj * HALF;
                    if (isgate) {
#pragma unroll
                        for (int e = 0; e < 4; ++e) { v0[e] = gelu_tanh(v0[e]); v1[e] = gelu_tanh(v1[e]); }
                    }
                    if (ok) *(u32x4*)(base + (size_t)row * DR + col) = pack8(v0, v1);
                    if (sdst) { *(f32x4*)(sdst + col) = v0; *(f32x4*)(sdst + col + 4) = v1; }
                }
            }
    }
};
template <bool F32OUT> struct EpiRes {
    static constexpr bool PERM = true, AFTER_DRAIN = false;
    const bf16_t* base; bf16_t* outb; float* outf; float* ssq;
    __device__ __forceinline__ void operator()(const f32x4 (&acc)[2][2][4][2], const Unit& u, int wr, int wc, int fr, int fq) const {
        const int colt = u.pn * BM + wc * 32 + 8 * fq;
        const size_t off0 = (size_t)(u.pm * BM + wr * 64 + fr) * DM + colt;
        u32x4 rb[8][2];
#pragma unroll
        for (int i = 0; i < 4; ++i)
#pragma unroll
            for (int bj = 0; bj < 2; ++bj) rb[i][bj] = *(const u32x4*)(base + off0 + (size_t)((i >> 2) * HALF + (i & 3) * 16) * DM + bj * HALF);
#pragma unroll
        for (int i = 0; i < 8; ++i) {
            const int ai = i >> 2, m = i & 3;
            if (i + 4 < 8) {
#pragma unroll
                for (int bj = 0; bj < 2; ++bj) rb[i + 4][bj] = *(const u32x4*)(base + off0 + (size_t)(((i + 4) >> 2) * HALF + ((i + 4) & 3) * 16) * DM + bj * HALF);
            }
            const int row = u.pm * BM + ai * HALF + wr * 64 + m * 16 + fr;
            const size_t off = off0 + (size_t)(ai * HALF + m * 16) * DM;
            float q = 0.f;
#pragma unroll
            for (int bj = 0; bj < 2; ++bj) {
                const u32x4 b = rb[i][bj];
                f32x4 v0 = acc[ai][bj][m][0], v1 = acc[ai][bj][m][1];
                v0[0] += bf_lo(b.x); v0[1] += bf_hi(b.x); v0[2] += bf_lo(b.y); v0[3] += bf_hi(b.y);
                v1[0] += bf_lo(b.z); v1[1] += bf_hi(b.z); v1[2] += bf_lo(b.w); v1[3] += bf_hi(b.w);
                q += (v0[0] * v0[0] + v0[1] * v0[1]) + (v0[2] * v0[2] + v0[3] * v0[3]) + (v1[0] * v1[0] + v1[1] * v1[1]) + (v1[2] * v1[2] + v1[3] * v1[3]);
                if (F32OUT) { *(f32x4*)(outf + off + bj * HALF) = v0; *(f32x4*)(outf + off + bj * HALF + 4) = v1; }
                else *(u32x4*)(outb + off + bj * HALF) = pack8(v0, v1);
            }
            q += __shfl_xor(q, 16); q += __shfl_xor(q, 32);
            if (fq == 0) __hip_atomic_fetch_add(ssq + row, q, __ATOMIC_RELAXED, __HIP_MEMORY_SCOPE_AGENT);
        }
    }
};
struct EpiUp {
    static constexpr bool PERM = true, AFTER_DRAIN = false;
    bf16_t* out; const float* ssq;
    __device__ __forceinline__ void operator()(const f32x4 (&acc)[2][2][4][2], const Unit& u, int wr, int wc, int fr, int fq) const {
        const int colt = u.pn * BM + wc * 32 + 8 * fq;
        float sc[2][4];
#pragma unroll
        for (int ai = 0; ai < 2; ++ai)
#pragma unroll
            for (int m = 0; m < 4; ++m) sc[ai][m] = ssq[u.pm * BM + ai * HALF + wr * 64 + m * 16 + fr];
#pragma unroll
        for (int ai = 0; ai < 2; ++ai)
#pragma unroll
            for (int m = 0; m < 4; ++m) {
                const int row = u.pm * BM + ai * HALF + wr * 64 + m * 16 + fr;
                const float s = __builtin_amdgcn_rsqf(sc[ai][m] * (1.0f / DM) + EPS);
#pragma unroll
                for (int bj = 0; bj < 2; ++bj) {
                    f32x4 v0 = acc[ai][bj][m][0] * s, v1 = acc[ai][bj][m][1] * s;
#pragma unroll
                    for (int e = 0; e < 4; ++e) { const float a = fmaxf(v0[e], 0.f), b = fmaxf(v1[e], 0.f); v0[e] = a * a; v1[e] = b * b; }
                    *(u32x4*)(out + (size_t)row * DFF + colt + bj * HALF) = pack8(v0, v1);
                }
            }
    }
};
struct EpiKVQ {
    static constexpr bool PERM = true, AFTER_DRAIN = false;
    const float* ssq; bf16_t *kb, *ckb; size_t bstride, cstride; float* out;
    __device__ __forceinline__ void operator()(const f32x4 (&acc)[2][2][4][2], const Unit& u, int wr, int wc, int fr, int fq) const {
        const int t = u.pn >> 2;
        const int colt = (u.pn & 3) * BM + wc * 32 + 8 * fq;
        bf16_t* bb = kb + (size_t)t * bstride;
        bf16_t* cb = ckb + (size_t)t * cstride;
        float* o_main = out + OFF_KP + (size_t)t * (OFF_VP - OFF_KP);
        float* o_samp = out + OFF_KS + (size_t)t * (OFF_VS - OFF_KS);
        float* o_meta = out + OFF_MK + (size_t)t * (OFF_MV - OFF_MK);
        float sc[2][4];
#pragma unroll
        for (int ai = 0; ai < 2; ++ai)
#pragma unroll
            for (int m = 0; m < 4; ++m) sc[ai][m] = ssq[u.pm * BM + ai * HALF + wr * 64 + m * 16 + fr];
#pragma unroll
        for (int ai = 0; ai < 2; ++ai)
#pragma unroll
            for (int m = 0; m < 4; ++m) {
                const int row = u.pm * BM + ai * HALF + wr * 64 + m * 16 + fr;
                const float s = __builtin_amdgcn_rsqf(sc[ai][m] * (1.0f / DM) + EPS);
#pragma unroll
                for (int bj = 0; bj < 2; ++bj) {
                    const f32x4 v0 = acc[ai][bj][m][0] * s, v1 = acc[ai][bj][m][1] * s;
                    const int col = colt + bj * HALF;
                    const u32x4 pk = pack8(v0, v1);
                    *(u32x4*)(bb + (size_t)row * DM + col) = pk;
                    if (t < 2) {
                        if (row < R_SAMP) { float* d = o_main + (size_t)row * DM + col; __builtin_nontemporal_store(v0, (f32x4*)d); __builtin_nontemporal_store(v1, (f32x4*)(d + 4)); }
                        else if (row < R_META) {
                            const int q = row - R_SAMP; float* d = o_samp + (size_t)q * DM + col; *(f32x4*)d = v0; *(f32x4*)(d + 4) = v1;
                            *(u32x4*)(cb + ((size_t)(q >> 5) * 1072 + 1040 + (q & 31)) * DM + col) = pk;
                        } else if (row < R_PAD) {
                            const int mm = row - R_META;
                            _Pragma("unroll 1") for (int b = 0; b < 16; ++b) { float* d = o_meta + (size_t)(b * 16 + mm) * DM + col; *(f32x4*)d = v0; *(f32x4*)(d + 4) = v1; }
                        }
                    }
                }
            }
    }
};

struct TailOrder {
    int pm0, nN, ntile, c;
    __host__ __device__ bool next(int i, Unit& u) const { if (i != 0 || c < 0 || c >= ntile) return false; u.pm = pm0 + c / nN; u.pn = c % nN; u.ko = 0; return true; }
    __device__ __forceinline__ void a_ready(const Unit&) const {}
    __device__ __forceinline__ void done(const Unit&) const {}
};
struct SplitKOrder {
    int pm0, nN, nunit, kbytes, c;
    __host__ __device__ bool next(int i, Unit& u) const { if (i != 0 || c < 0 || c >= nunit) return false; const int t = c >> 2; u.pm = pm0 + t / nN; u.pn = t % nN; u.ko = (c & 3) * kbytes; return true; }
    __device__ __forceinline__ void a_ready(const Unit&) const {}
    __device__ __forceinline__ void done(const Unit&) const {}
};
struct EpiAcc {
    static constexpr bool PERM = true, AFTER_DRAIN = false;
    float* accf; int row0;
    __device__ __forceinline__ void operator()(const f32x4 (&acc)[2][2][4][2], const Unit& u, int wr, int wc, int fr, int fq) const {
        const int colt = u.pn * BM + wc * 32 + 8 * fq;
#pragma unroll
        for (int ai = 0; ai < 2; ++ai)
#pragma unroll
            for (int m = 0; m < 4; ++m) {
                const int row = u.pm * BM + ai * HALF + wr * 64 + m * 16 + fr;
#pragma unroll
                for (int bj = 0; bj < 2; ++bj) {
                    float* d = accf + (size_t)(row - row0) * DM + colt + bj * HALF;
#pragma unroll
                    for (int e = 0; e < 4; ++e) { __hip_atomic_fetch_add(d + e, acc[ai][bj][m][0][e], __ATOMIC_RELAXED, __HIP_MEMORY_SCOPE_AGENT); __hip_atomic_fetch_add(d + 4 + e, acc[ai][bj][m][1][e], __ATOMIC_RELAXED, __HIP_MEMORY_SCOPE_AGENT); }
                }
            }
    }
};
template <class Epi, class Sched, bool ALIGN_EPI = false, bool SP2 = false>
__device__ __forceinline__ void gemm_phase(PG8_LAS unsigned char* lds, const Gemm g, const Sched& S, const Epi& E) {
    const int tid = otid(), wid = __builtin_amdgcn_readfirstlane(tid >> 6), lane = tid & 63, wr = wid >> 2, wc = wid & 3, fr = lane & 15, fq = lane >> 4;
    const int K = g.ld ? g.ld : g.K, nt = g.K / BK;
    unsigned voffA[2], voffB[2];
#pragma unroll
    for (int i = 0; i < 2; ++i) { int R, C; stage_rc(tid * 16 + i * 8192, R, C); const int Rb = Epi::PERM ? ((R & ~31) + perm32(R & 31)) : R;
        voffA[i] = (unsigned)(R * K + C) * 2u; voffB[i] = (unsigned)(Rb * K + C) * 2u; }
    const size_t kstep = (size_t)(BK * 2);
    const size_t hstep = (size_t)HALF * K * 2;
    const size_t tstep = 2 * hstep;
    const unsigned ldsw = (unsigned)wid * 1024u;
    const int aoff = lds_byte(wr * 64 + fr, fq * 8), boff = lds_byte(wc * 32 + fr, fq * 8);
#define PG8_SA(b, h) (((b) * 2 + (h)) * HTB)
#define PG8_SB(b, h) ((4 + (b) * 2 + (h)) * HTB)
#define PG8_STAGE(bufoff, gbase, voff) do { _Pragma("unroll") for (int _i = 0; _i < 2; ++_i) \
        __builtin_amdgcn_global_load_lds((const unsigned*)((const char*)(gbase) + (voff)[_i]), (PG8_LAS unsigned*)(lds + (bufoff) + ldsw + _i * 8192), 16, 0, 0); } while (0)
#define PG8_LDA(dst, b, h) do { _Pragma("unroll") for (int m = 0; m < 4; ++m) _Pragma("unroll") for (int k = 0; k < 2; ++k) dst[m][k] = *(const PG8_LAS bf16x8*)(lds + PG8_SA(b, h) + aoff + m * 2048 + k * 1024); } while (0)
#define PG8_LDB(dst, b, h) do { _Pragma("unroll") for (int n = 0; n < 2; ++n) _Pragma("unroll") for (int k = 0; k < 2; ++k) dst[n][k] = *(const PG8_LAS bf16x8*)(lds + PG8_SB(b, h) + boff + n * 2048 + k * 1024); } while (0)
#define PG8_MMA(ai, bj, At, Bt) do { __builtin_amdgcn_s_setprio(1); _Pragma("unroll") for (int m = 0; m < 4; ++m) _Pragma("unroll") for (int n = 0; n < 2; ++n) _Pragma("unroll") for (int k = 0; k < 2; ++k) \
        acc[ai][bj][m][n] = __builtin_amdgcn_mfma_f32_16x16x32_bf16(Bt[n][k], At[m][k], acc[ai][bj][m][n], 0, 0, 0); __builtin_amdgcn_s_setprio(0); } while (0)
#define PG8_WAIT_V(n) asm volatile("s_waitcnt vmcnt(" #n ")" ::: "memory")
#define PG8_WAIT_L(n) asm volatile("s_waitcnt lgkmcnt(" #n ")" ::: "memory")
#define PG8_BAR __builtin_amdgcn_s_barrier()
#define PG8_SCHED __builtin_amdgcn_sched_barrier(0)
    Unit cur, nxt; int ui = 0;
    if (!S.next(0, cur)) return;
    f32x4 acc[2][2][4][2];
#pragma unroll
    for (int a = 0; a < 2; ++a)
#pragma unroll
        for (int b = 0; b < 2; ++b)
#pragma unroll
            for (int m = 0; m < 4; ++m)
#pragma unroll
                for (int n = 0; n < 2; ++n) acc[a][b][m][n] = (f32x4){0.f, 0.f, 0.f, 0.f};
    bf16x8 At[4][2], B0[2][2], B1[2][2];
    const char* cA = (const char*)g.A + (size_t)cur.pm * tstep + cur.ko; const char* cB = (const char*)g.Bt + (size_t)cur.pn * tstep + cur.ko;
    S.a_ready(cur);
    if constexpr (SP2) {
        PG8_STAGE(PG8_SB(0, 0), cB, voffB); PG8_STAGE(PG8_SB(0, 1), cB + hstep, voffB); PG8_STAGE(PG8_SA(0, 0), cA, voffA); PG8_STAGE(PG8_SA(0, 1), cA + hstep, voffA);
        if (wr == 1) PG8_BAR;
        PG8_WAIT_V(2); PG8_BAR;
        PG8_STAGE(PG8_SB(1, 0), cB + kstep, voffB); PG8_STAGE(PG8_SA(1, 0), cA + kstep, voffA); PG8_STAGE(PG8_SB(1, 1), cB + hstep + kstep, voffB);
        PG8_WAIT_V(6); PG8_BAR;
    } else {
        PG8_STAGE(PG8_SB(0, 0), cB, voffB); PG8_STAGE(PG8_SA(0, 0), cA, voffA); PG8_STAGE(PG8_SB(0, 1), cB + hstep, voffB); PG8_STAGE(PG8_SA(0, 1), cA + hstep, voffA);
        if (wr == 1) PG8_BAR;
        PG8_WAIT_V(4); PG8_BAR;
        PG8_STAGE(PG8_SB(1, 0), cB + kstep, voffB); PG8_STAGE(PG8_SA(1, 0), cA + kstep, voffA); PG8_STAGE(PG8_SB(1, 1), cB + hstep + kstep, voffB);
        PG8_WAIT_V(6); PG8_BAR;
    }
    for (;;) {
        const bool has_next = S.next(ui + 1, nxt);
        const char* nA = has_next ? (const char*)g.A + (size_t)nxt.pm * tstep + nxt.ko : cA; const char* nB = has_next ? (const char*)g.Bt + (size_t)nxt.pn * tstep + nxt.ko : cB;
        for (int t = 0; t < nt; t += 2) {
            const bool last = (t == nt - 2);
            const char* a1 = cA + (size_t)(t + 1) * kstep;
            const char* a2 = last ? nA : cA + (size_t)(t + 2) * kstep; const char* b2 = last ? nB : cB + (size_t)(t + 2) * kstep;
            const char* a3 = a2 + kstep; const char* b3 = b2 + kstep;
            if (last && has_next) S.a_ready(nxt);
            if constexpr (SP2) {
            PG8_LDB(B0, 0, 0); PG8_LDB(B1, 0, 1); PG8_SCHED; PG8_LDA(At, 0, 0); PG8_STAGE(PG8_SA(1, 1), a1 + hstep, voffA);
            PG8_WAIT_V(8); PG8_WAIT_L(0); PG8_BAR; PG8_MMA(0, 0, At, B0); PG8_MMA(0, 1, At, B1); PG8_BAR; PG8_SCHED;
            PG8_LDA(At, 0, 1); PG8_STAGE(PG8_SB(0, 0), b2, voffB); PG8_STAGE(PG8_SB(0, 1), b2 + hstep, voffB); PG8_STAGE(PG8_SA(0, 0), a2, voffA);
            PG8_WAIT_V(8); PG8_WAIT_L(0); PG8_BAR; PG8_MMA(1, 0, At, B0); PG8_MMA(1, 1, At, B1); PG8_BAR; PG8_SCHED;
            PG8_LDB(B0, 1, 0); PG8_LDB(B1, 1, 1); PG8_SCHED; PG8_LDA(At, 1, 0); PG8_STAGE(PG8_SA(0, 1), a2 + hstep, voffA);
            PG8_WAIT_V(8); PG8_WAIT_L(0); PG8_BAR; PG8_MMA(0, 0, At, B0); PG8_MMA(0, 1, At, B1); PG8_BAR; PG8_SCHED;
            PG8_LDA(At, 1, 1); PG8_STAGE(PG8_SB(1, 0), b3, voffB); PG8_STAGE(PG8_SB(1, 1), b3 + hstep, voffB); PG8_STAGE(PG8_SA(1, 0), a3, voffA);
            PG8_WAIT_V(8); PG8_WAIT_L(0); PG8_BAR; PG8_MMA(1, 0, At, B0); PG8_MMA(1, 1, At, B1); PG8_BAR; PG8_SCHED;
            } else {
            PG8_LDB(B0, 0, 0); PG8_SCHED; PG8_LDA(At, 0, 0); PG8_STAGE(PG8_SA(1, 1), a1 + hstep, voffA);
            PG8_WAIT_L(8); PG8_BAR; PG8_WAIT_L(0); PG8_MMA(0, 0, At, B0); PG8_BAR; PG8_SCHED;
            PG8_LDB(B1, 0, 1); PG8_STAGE(PG8_SB(0, 0), b2, voffB);
            PG8_BAR; PG8_WAIT_L(0); PG8_MMA(0, 1, At, B1); PG8_BAR;
            PG8_LDA(At, 0, 1); PG8_STAGE(PG8_SA(0, 0), a2, voffA);
            PG8_BAR; PG8_WAIT_L(0); PG8_MMA(1, 0, At, B0); PG8_BAR; PG8_SCHED;
            PG8_STAGE(PG8_SB(0, 1), b2 + hstep, voffB);
            PG8_WAIT_V(6); PG8_BAR; PG8_MMA(1, 1, At, B1); PG8_BAR;
            PG8_LDB(B0, 1, 0); PG8_SCHED; PG8_LDA(At, 1, 0); PG8_STAGE(PG8_SA(0, 1), a2 + hstep, voffA);
            PG8_WAIT_L(8); PG8_BAR; PG8_WAIT_L(0); PG8_MMA(0, 0, At, B0); PG8_BAR; PG8_SCHED;
            PG8_LDB(B1, 1, 1); PG8_STAGE(PG8_SB(1, 0), b3, voffB);
            PG8_BAR; PG8_WAIT_L(0); PG8_MMA(0, 1, At, B1); PG8_BAR;
            PG8_LDA(At, 1, 1); PG8_STAGE(PG8_SA(1, 0), a3, voffA);
            PG8_BAR; PG8_WAIT_L(0); PG8_MMA(1, 0, At, B0); PG8_BAR; PG8_SCHED;
            PG8_STAGE(PG8_SB(1, 1), b3 + hstep, voffB);
            PG8_WAIT_V(6); PG8_BAR; PG8_MMA(1, 1, At, B1); PG8_BAR;
            }
        }
        if constexpr (ALIGN_EPI) { if (wr == 0) PG8_BAR; }
        if constexpr (!Epi::AFTER_DRAIN) { E(acc, cur, wr, wc, fr, fq); S.done(cur); }
        if (!has_next) break;
#pragma unroll
        for (int a = 0; a < 2; ++a)
#pragma unroll
            for (int b = 0; b < 2; ++b)
#pragma unroll
                for (int m = 0; m < 4; ++m)
#pragma unroll
                    for (int n = 0; n < 2; ++n) acc[a][b][m][n] = (f32x4){0.f, 0.f, 0.f, 0.f};
        cur = nxt; cA = nA; cB = nB; ++ui;
        if constexpr (ALIGN_EPI) { if (wr == 1) PG8_BAR; }
    }
    PG8_WAIT_V(0);
    if constexpr (!ALIGN_EPI) { if (wr == 0) PG8_BAR; }
    PG8_BAR;
    if constexpr (Epi::AFTER_DRAIN) { E.fused(acc, cur, wr, wc, fr, fq, lds, wid, lane); S.done(cur); }
#undef PG8_SA
#undef PG8_SB
#undef PG8_STAGE
#undef PG8_LDA
#undef PG8_LDB
#undef PG8_MMA
#undef PG8_WAIT_V
#undef PG8_WAIT_L
#undef PG8_BAR
#undef PG8_SCHED
}
}

#define LAS __attribute__((address_space(3)))
typedef unsigned short bf16;
typedef unsigned v4u __attribute__((ext_vector_type(4)));
typedef unsigned v2u __attribute__((ext_vector_type(2)));
typedef float f32x4 __attribute__((ext_vector_type(4)));
typedef float f32x16 __attribute__((ext_vector_type(16)));
typedef short bf16x8 __attribute__((ext_vector_type(8)));
typedef short v4i16_t __attribute__((ext_vector_type(4)));
__device__ __forceinline__ unsigned f2bf(float f) { unsigned u = __builtin_bit_cast(unsigned, f); return (u + 0x7fffu + ((u >> 16) & 1u)) >> 16; }
__device__ __forceinline__ unsigned pk2(float lo, float hi) { return f2bf(lo) | (f2bf(hi) << 16); }
__device__ __forceinline__ float bflo(unsigned w) { return __uint_as_float(w << 16); }
__device__ __forceinline__ float bfhi(unsigned w) { return __uint_as_float(w & 0xffff0000u); }
__device__ __forceinline__ float wave_sum(float v) {
#pragma unroll
    for (int o = 1; o < 64; o <<= 1) v += __shfl_xor(v, o);
    return v;
}
#define LDS_WAIT() asm volatile("s_waitcnt lgkmcnt(0)" ::: "memory")

#define XB_TMO      128
#define XB_XCNT(j)  (256  + 64 * (j))
#define XB_XSUB(j)  (1280 + 64 * (j))
#define XB_XGEN(j)  (2304 + 64 * (j))
#define XB_TOP      3328
#define XB_TOPGEN   3392
#define XCD_BAR_WORDS 3456
#define XB_SPIN_CAP (1u << 18)

__device__ __forceinline__ unsigned xb_ld(unsigned* p)              { return __hip_atomic_load(p, __ATOMIC_RELAXED, __HIP_MEMORY_SCOPE_AGENT); }
__device__ __forceinline__ unsigned xb_add(unsigned* p, unsigned v) { return __hip_atomic_fetch_add(p, v, __ATOMIC_RELAXED, __HIP_MEMORY_SCOPE_AGENT); }
__device__ __forceinline__ unsigned xb_xcc_id() { return (unsigned)__builtin_amdgcn_s_getreg((3 << 11) | 20) & 0xFu; }
#define XB_SPIN(cond, bar) do { unsigned _sp = 0; while (cond) { __builtin_amdgcn_s_sleep(1); \
    if ((++_sp & 255u) == 0u) { if (xb_ld(&(bar)[XB_TMO])) break; if (_sp > XB_SPIN_CAP) { atomicAdd(&(bar)[XB_TMO], 1u); break; } } } } while (0)

struct XcdBarrier {
    unsigned* bar; unsigned x;
    volatile LAS unsigned* st;
};

__device__ __forceinline__ XcdBarrier xcd_barrier_post(unsigned* bar, volatile LAS unsigned* st) {
    XcdBarrier b; b.bar = bar; b.x = xb_xcc_id(); b.st = st;
    if (threadIdx.x == 0) (void)xb_add(&bar[XB_XCNT(b.x)], 1u);
    return b;
}
__device__ __forceinline__ void xcd_barrier_complete(unsigned* bar, unsigned x, unsigned& nloc, unsigned& nx) {
    const unsigned G = gridDim.x * gridDim.y * gridDim.z;
    unsigned sum, cnt, mine, sp = 0u;
    for (;;) {
        sum = 0u; cnt = 0u; mine = 0u;
#pragma unroll
        for (unsigned j = 0; j < 16; ++j) { const unsigned c = xb_ld(&bar[XB_XCNT(j)]); sum += c; cnt += (c > 0u) ? 1u : 0u; mine = (j == x) ? c : mine; }
        if (sum == G) break;
        __builtin_amdgcn_s_sleep(1);
        if ((++sp & 255u) == 0u) { if (xb_ld(&bar[XB_TMO])) break; if (sp > XB_SPIN_CAP) { atomicAdd(&bar[XB_TMO], 1u); break; } }
    }
    nloc = mine > 0u ? mine : 1u; nx = cnt > 0u ? cnt : 1u;
}

__device__ __forceinline__ void xcd_barrier(const XcdBarrier& b) {
    asm volatile("s_waitcnt vmcnt(0)" ::: "memory");
    __syncthreads();
    if (threadIdx.x == 0) {
        unsigned* bar = b.bar;
        __builtin_amdgcn_s_waitcnt(0);
        unsigned nloc = b.st[0], nx = b.st[1];
        if (nloc == 0u) { xcd_barrier_complete(bar, b.x, nloc, nx); b.st[0] = nloc; b.st[1] = nx; }
        const unsigned old = xb_add(&bar[XB_XSUB(b.x)], 1u);
        const unsigned gen = old / nloc;
        if (old + 1u == (gen + 1u) * nloc) {
            __builtin_amdgcn_fence(__ATOMIC_RELEASE, "agent");
            asm volatile("s_waitcnt vmcnt(0)" ::: "memory");
            const unsigned og = xb_add(&bar[XB_TOP], 1u);
            const unsigned tg = og / nx;
            if (og + 1u == (tg + 1u) * nx) xb_add(&bar[XB_TOPGEN], 1u);
            else XB_SPIN(xb_ld(&bar[XB_TOPGEN]) == tg, bar);
            __builtin_amdgcn_fence(__ATOMIC_ACQUIRE, "agent");
            xb_add(&bar[XB_XGEN(b.x)], 1u);
            asm volatile("s_waitcnt vmcnt(0)" ::: "memory");
        } else {
            XB_SPIN(xb_ld(&bar[XB_XGEN(b.x)]) == gen, bar);
            __builtin_amdgcn_fence(__ATOMIC_ACQUIRE, "agent");
            asm volatile("s_waitcnt vmcnt(0)" ::: "memory");
        }
    }
    __syncthreads();
}

constexpr size_t MiB = 1u << 20;
constexpr size_t WS_ACC = 7 * MiB;
constexpr size_t WS_RS0 = 1 * MiB, WS_SSQ1 = 2 * MiB, WS_SSQ2 = 3 * MiB, WS_SSQ3 = 4 * MiB, WS_SSQ4 = 5 * MiB, WS_LUT = 6 * MiB;
constexpr size_t WS_WIN = 8 * MiB, WS_WOUT = 13 * MiB, WS_WUP0 = 16 * MiB, WS_WDN0 = 24 * MiB, WS_WKVQ = 32 * MiB, WS_WO = 38 * MiB,
                 WS_WUP1 = 40 * MiB, WS_WDN1 = 48 * MiB, WS_WG = 56 * MiB, WS_CKB = 58 * MiB, WS_CVB = 75 * MiB;
constexpr size_t WS_ACT = 96 * MiB;
constexpr size_t WS_GATE = 96 * MiB, WS_XR = 258 * MiB, WS_Z = 420 * MiB;
constexpr size_t WS_KB = 96 * MiB, WS_VB = 225 * MiB, WS_QB = 354 * MiB, WS_OB = 483 * MiB;
constexpr size_t WS_H0 = 612 * MiB, WS_H1 = 741 * MiB, WS_H2 = 870 * MiB, WS_H3 = 612 * MiB, WS_END = 999 * MiB;

namespace att {
constexpr int RSK = 272, TILEB = 16384, KST = 0, VST = 3 * TILEB, LUT_OFF = 6 * TILEB;
__device__ __forceinline__ void glds16(const void* gsrc, unsigned lds_dst) { unsigned keep;
  asm volatile("s_mov_b32 %0, m0\n\ts_mov_b32 m0, %2\n\ts_nop 0\n\tglobal_load_lds_dwordx4 %1, off\n\ts_mov_b32 m0, %0" : "=&s"(keep) : "v"(gsrc), "s"(lds_dst) : "memory"); }
constexpr float NEG = -1e30f;
__device__ __forceinline__ int crow(int r, int hi) { return (r & 3) + 8 * (r >> 2) + 4 * hi; }
typedef float f32x2_t __attribute__((ext_vector_type(2))); typedef __bf16 bf16x2_t __attribute__((ext_vector_type(2)));
__device__ __forceinline__ float max3f(float a, float b, float c) { float r; asm("v_max3_f32 %0, %1, %2, %3" : "=v"(r) : "v"(a), "v"(b), "v"(c)); return r; }
__device__ __forceinline__ unsigned cvtpk(float lo, float hi) { f32x2_t v = {lo, hi}; bf16x2_t b = __builtin_convertvector(v, bf16x2_t); return __builtin_bit_cast(unsigned, b); }

__device__ __forceinline__ void attn_unit(LAS unsigned char* lds, const bf16* Qh, bf16* Oh, int nqw, int qpos0,
                                          const bf16* kmeta, const bf16* vmeta, const bf16* kmain, const bf16* vmain, int nmain,
                                          const float* lut_g, float c15, float lam, int abl, const bool ksplit) {
    const int tid = otid(), lane = tid & 63, r32 = lane & 31, hi = lane >> 5;
    const int wid = __builtin_amdgcn_readfirstlane(tid >> 6), pair = wid >> 1, map = wid & 1;
    const bool active = ksplit || pair < nqw;
    const int qposw = qpos0 + (ksplit ? 0 : 32 * pair);
    const int tmask = ksplit ? 3 : 0, tsel = ksplit ? pair : 0;
    int klim = 64 * (qposw / 64 + 1); klim = klim < nmain ? klim : nmain;
    const int ntw = active ? 1 + (klim + 63) / 64 : 0;
    int klimb = 64 * ((qpos0 + 32 * (nqw - 1)) / 64 + 1); klimb = klimb < nmain ? klimb : nmain;
    const int nt = 1 + (klimb + 63) / 64;
    LAS float* lut = (LAS float*)(lds + LUT_OFF);
    constexpr int QST = LUT_OFF + 1024;
    const int qoff = QST + ((active && !ksplit ? 32 * pair : 0) + r32) * RSK + (64 * map + 8 * hi) * 2;
    f32x16 o[4];
#pragma unroll
    for (int d = 0; d < 4; ++d)
#pragma unroll
        for (int r = 0; r < 16; ++r) o[d][r] = 0.f;
    float lrow = 0.f;
    const unsigned ldsb = (unsigned)(uintptr_t)lds;
    const int dr0 = 8 * wid + (lane >> 4), dr1 = dr0 + 4, dsl = lane & 15;
    const int kc0 = (dsl ^ (dr0 & 15)) * 8, kc1 = (dsl ^ (dr1 & 15)) * 8, vc0 = (dsl ^ ((dr0 & 3) << 2)) * 8;
#define ATT_SRC(t, pm_, pn_) const int t_ = (t); const bf16* src_; int nv_; \
        if (t_ == 0) { src_ = pm_; nv_ = 16; } else { const int k0_ = 64 * (t_ - 1); src_ = pn_ + (size_t)k0_ * DM; nv_ = nmain - k0_; nv_ = nv_ > 64 ? 64 : nv_; } \
        const int ra_ = dr0 < nv_ ? dr0 : nv_ - 1, rb_ = dr1 < nv_ ? dr1 : nv_ - 1;
#define ATT_DMAK(t, s) do { ATT_SRC(t, kmeta, kmain) const unsigned d_ = (unsigned)__builtin_amdgcn_readfirstlane(ldsb + KST + (s) * TILEB + wid * 2048); \
        glds16(src_ + (size_t)ra_ * DM + kc0, d_); glds16(src_ + (size_t)rb_ * DM + kc1, d_ + 1024); } while (0)
#define ATT_DMAV(t, s) do { ATT_SRC(t, vmeta, vmain) const unsigned d_ = (unsigned)__builtin_amdgcn_readfirstlane(ldsb + VST + (s) * TILEB + wid * 2048); \
        glds16(src_ + (size_t)ra_ * DM + vc0, d_); glds16(src_ + (size_t)rb_ * DM + vc0, d_ + 1024); } while (0)
#define ATT_WAITBAR(n) asm volatile("s_waitcnt vmcnt(" #n ") lgkmcnt(0)\n\ts_barrier" ::: "memory")
    const int kx = KST + r32 * 256 + (((8 * map + hi) ^ (r32 & 15)) << 4);
    const int vq_ = (lane >> 2) & 3;
    const int vx = VST + (4 * hi + vq_) * 256 + (2 * ((lane >> 4) & 1) + ((lane & 3) >> 1)) * 16 + (lane & 1) * 8;
    int vxd[4];
#pragma unroll
    for (int d = 0; d < 4; ++d) vxd[d] = vx + ((d ^ vq_) << 6);
    const int qpos = qposw + r32;
    const bool qk_first = wid < 4;
#define ATT_QK(t, sk, S0, S1) do { const int tq_ = (t); const int kp_ = tq_ == 0 ? -16 : 64 * (tq_ - 1); \
        LAS unsigned char* kb_ = lds + (sk) * TILEB; \
        _Pragma("unroll") for (int r = 0; r < 16; ++r) { S0[r] = 0.f; S1[r] = 0.f; } \
        __builtin_amdgcn_s_setprio(1); \
        _Pragma("unroll") for (int ds = 0; ds < 4; ++ds) { \
            const bf16x8 ka_ = *(const LAS bf16x8*)(kb_ + (kx ^ (ds << 5))); const bf16x8 kc_ = *(const LAS bf16x8*)(kb_ + (kx ^ (ds << 5)) + 8192); \
            S0 = __builtin_amdgcn_mfma_f32_32x32x16_bf16(ka_, qf[ds], S0, 0, 0, 0); S1 = __builtin_amdgcn_mfma_f32_32x32x16_bf16(kc_, qf[ds], S1, 0, 0, 0); } \
        __builtin_amdgcn_s_setprio(0); } while (0)
#define ATT_SMPV(t, sv, S0, S1, SX0, SX1) do { const int ts_ = (t); \
        LAS unsigned char* vb_ = lds + (sv) * TILEB; \
        const int kpos0 = ts_ == 0 ? -16 : 64 * (ts_ - 1); \
        int nvalid = ts_ == 0 ? 16 : (nmain - kpos0); nvalid = nvalid > 64 ? 64 : nvalid; \
        if ((qposw - (kpos0 + 63)) < 128) { \
            const int rb = kpos0 - qpos + 128; \
            _Pragma("unroll") for (int r = 0; r < 16; ++r) { int i0 = rb + crow(r, hi); i0 = i0 < 0 ? 0 : i0; S0[r] += lut[i0]; } \
            _Pragma("unroll") for (int r = 0; r < 16; ++r) { int i1 = rb + 32 + crow(r, hi); i1 = i1 < 0 ? 0 : (i1 > 191 ? 191 : i1); S1[r] += lut[i1]; } \
        } \
        if (nvalid < 64) { \
            _Pragma("unroll") for (int r = 0; r < 16; ++r) { const int kv = crow(r, hi); if (kv >= nvalid) S0[r] = NEG; if (kv + 32 >= nvalid) S1[r] = NEG; } \
        } \
        float ls = 0.f; \
        _Pragma("unroll") for (int ks = 0; ks < 4; ++ks) { \
            float e_[8]; \
            _Pragma("unroll") for (int j = 0; j < 8; ++j) { e_[j] = __builtin_amdgcn_exp2f(ks < 2 ? S0[8 * (ks & 1) + j] : S1[8 * (ks & 1) + j]); ls += e_[j]; } \
            v4u pw_; pw_.x = cvtpk(e_[0], e_[1]); pw_.y = cvtpk(e_[2], e_[3]); pw_.z = cvtpk(e_[4], e_[5]); pw_.w = cvtpk(e_[6], e_[7]); \
            __builtin_amdgcn_s_setprio(1); \
            _Pragma("unroll") for (int d = 0; d < 4; ++d) { \
                const v4i16_t lo = __builtin_amdgcn_ds_read_tr16_b64_v4i16((LAS v4i16_t*)(vb_ + vxd[d] + ks * 4096)); \
                const v4i16_t hh = __builtin_amdgcn_ds_read_tr16_b64_v4i16((LAS v4i16_t*)(vb_ + vxd[d] + ks * 4096 + 2048)); \
                const bf16x8 vf = (bf16x8){lo[0], lo[1], lo[2], lo[3], hh[0], hh[1], hh[2], hh[3]}; \
                o[d] = __builtin_amdgcn_mfma_f32_32x32x16_bf16(vf, __builtin_bit_cast(bf16x8, pw_), o[d], 0, 0, 0); } \
            __builtin_amdgcn_s_setprio(0); \
        } \
        lrow += ls; } while (0)
#define ATT_STEP(t) do { const int tt_ = (t); \
        if (tt_ + 2 < nt) { ATT_DMAK(tt_ + 2, s2); ATT_DMAV(tt_ + 2, s2); } \
        if (tt_ < ntw && (tt_ & tmask) == tsel) { \
            if (!(abl & 2)) ATT_QK(tt_, s0, sa0, sa1); \
            if (!(abl & 1)) ATT_SMPV(tt_, s0, sa0, sa1, sa0, sa1); } \
        if (tt_ + 2 < nt) ATT_WAITBAR(4); else ATT_WAITBAR(0); \
        { const int r_ = s0; s0 = s1; s1 = s2; s2 = r_; } } while (0)
    asm volatile("s_waitcnt vmcnt(0)" ::: "memory");
    ATT_DMAK(0, 0); ATT_DMAV(0, 0); ATT_DMAK(1, 1); ATT_DMAV(1, 1);
    if (tid < 192) lut[tid] = lut_g[tid] - c15;
    for (int c = tid; c < nqw * 32 * 16; c += 512) *(LAS v4u*)(lds + QST + (c >> 4) * RSK + (c & 15) * 16) = *(const v4u*)(Qh + (size_t)(c >> 4) * DM + (c & 15) * 8);
    ATT_WAITBAR(0);
    bf16x8 qf[4];
#pragma unroll
    for (int ds = 0; ds < 4; ++ds) qf[ds] = *(const LAS bf16x8*)(lds + qoff + ds * 32);
    int s0 = 0, s1 = 1, s2 = 2;
    f32x16 sa0, sa1;
#pragma unroll
    for (int r = 0; r < 16; ++r) { sa0[r] = 0.f; sa1[r] = 0.f; }
    for (int t = 0; t < nt; ++t) ATT_STEP(t);
#undef ATT_SRC
#undef ATT_DMAK
#undef ATT_DMAV
#undef ATT_WAITBAR
#undef ATT_QK
#undef ATT_SMPV
#undef ATT_STEP
    if (ksplit) {
        LAS float* Xs = (LAS float*)lds + ((pair - 1) * 2 + map) * (65 * 64) + lane;
        if (pair > 0) {
#pragma unroll
            for (int d = 0; d < 4; ++d)
#pragma unroll
                for (int r = 0; r < 16; ++r) Xs[(d * 16 + r) * 64] = o[d][r];
            Xs[64 * 64] = lrow;
        }
        __syncthreads();
        if (pair == 0) {
#pragma unroll 1
            for (int p = 0; p < 3; ++p) {
                const LAS float* Xr = (const LAS float*)lds + (p * 2 + map) * (65 * 64) + lane;
#pragma unroll
                for (int d = 0; d < 4; ++d)
#pragma unroll
                    for (int r = 0; r < 16; ++r) o[d][r] += Xr[(d * 16 + r) * 64];
                lrow += Xr[64 * 64];
            }
        }
        __syncthreads();
    }
    const bool fin = ksplit ? pair == 0 : active;
    lrow += __shfl_xor(lrow, 32);
    const float inv = 1.0f / lrow;
    LAS float* X = (LAS float*)lds + pair * 4096 + lane;
    if (fin && map == 1) {
#pragma unroll
        for (int d = 0; d < 4; ++d)
#pragma unroll
            for (int r = 0; r < 16; ++r) X[(d * 16 + r) * 64] = o[d][r] * inv;
    }
    __syncthreads();
    if (fin && map == 0) {
        float q = 0.f;
#pragma unroll
        for (int d = 0; d < 4; ++d)
#pragma unroll
            for (int r = 0; r < 16; ++r) { const float v = o[d][r] * inv - lam * X[(d * 16 + r) * 64]; o[d][r] = v; q += v * v; }
        q += __shfl_xor(q, 32);
        const float rs = __builtin_amdgcn_rsqf(q * (1.0f / 128.0f) + EPS);
        bf16* op = Oh + (size_t)((ksplit ? 0 : 32 * pair) + r32) * DM + 4 * hi;
#pragma unroll
        for (int d = 0; d < 4; ++d)
#pragma unroll
            for (int g = 0; g < 4; ++g) {
                v2u w; w.x = pg8::cvt_pk_bf16(o[d][4 * g] * rs, o[d][4 * g + 1] * rs); w.y = pg8::cvt_pk_bf16(o[d][4 * g + 2] * rs, o[d][4 * g + 3] * rs);
                *(v2u*)(op + 32 * d + 8 * g) = w;
            }
    }
    __syncthreads();
}
}

struct Args {
    const float* in[33];
    float* out; unsigned char* ws;
};

__device__ __forceinline__ void p0_transpose_item(const float* W, int K, int N, bf16* WT, int row_off, const float* gain, int gmask, float scal, LAS float* scr, int item, int lane) {
    const int nblk = N / 32, kb = item / nblk, nb = item % nblk, k0 = 64 * kb, n0 = 32 * nb;
#pragma unroll 8
    for (int i = 0; i < 32; ++i) { const int kk = 2 * i + (lane >> 5); const float g = gain ? gain[(k0 + kk) & gmask] * scal : scal;
        scr[kk * 33 + (lane & 31)] = W[(size_t)(k0 + kk) * N + n0 + (lane & 31)] * g; }
    LDS_WAIT(); asm volatile("" ::: "memory");
    const int c = lane & 7;
#pragma unroll
    for (int j = 0; j < 4; ++j) { const int n = (lane >> 3) + 8 * j; const LAS float* s = scr + (8 * c) * 33 + n;
        v4u o; o.x = pk2(s[0 * 33], s[1 * 33]); o.y = pk2(s[2 * 33], s[3 * 33]); o.z = pk2(s[4 * 33], s[5 * 33]); o.w = pk2(s[6 * 33], s[7 * 33]);
        *(v4u*)(WT + (size_t)(row_off + n0 + n) * K + k0 + 8 * c) = o; }
    LDS_WAIT(); asm volatile("" ::: "memory");
}
__device__ __forceinline__ float row_to_bf16(const float* xrow, bf16* orow, int lane) {
    const f32x4* xr = (const f32x4*)xrow + lane;
    f32x4 v[4]; float s = 0.f;
#pragma unroll
    for (int j = 0; j < 4; ++j) { v[j] = xr[64 * j]; s += (v[j].x * v[j].x + v[j].y * v[j].y) + (v[j].z * v[j].z + v[j].w * v[j].w); }
    v2u* o8 = (v2u*)orow + lane;
#pragma unroll
    for (int j = 0; j < 4; ++j) { v2u w; w.x = pk2(v[j].x, v[j].y); w.y = pk2(v[j].z, v[j].w); o8[64 * j] = w; }
    return wave_sum(s);
}
__device__ __forceinline__ int t5_bucket(int rel) {
    const int ret = rel > 0 ? 16 : 0; const int n = rel < 0 ? -rel : rel;
    int b;
    if (n < 8) b = n; else if (n < 12) b = 8; else if (n < 16) b = 9; else if (n < 23) b = 10; else if (n < 32) b = 11;
    else if (n < 46) b = 12; else if (n < 64) b = 13; else if (n < 91) b = 14; else b = 15;
    return ret + b;
}

enum { I_XP = 0, I_XS, I_SH, I_SC, I_CMK, I_CMV, I_CK, I_CV, I_META, I_GMIX, I_GMLP, I_WUP, I_WDN, I_WIN, I_CONVW, I_CONVB,
       I_WGR, I_BGR, I_WGI, I_BGI, I_LAM, I_WOUT, I_GKV, I_WKV, I_WQ, I_LQ1, I_LK1, I_LQ2, I_LK2, I_GSUB, I_WO, I_RELB, I_GF };

__device__ __forceinline__ void p0_prologue(const Args& A, LAS unsigned char* lds) {
    unsigned char* ws = A.ws;
    const int tid_ = otid(), lane = tid_ & 63, wave = __builtin_amdgcn_readfirstlane(tid_ >> 6);
    LAS float* scr = (LAS float*)(lds + wave * 16384);
    const int gw = blockIdx.x * 8 + wave, NGW = gridDim.x * 8;
    constexpr int N_IN = 16 * 80, N_OUT = 20 * 32, N_UP = 16 * 128, N_DN = 64 * 32, N_KV = 16 * 64, N_Q = 16 * 32, N_O = 16 * 32, N_G = 80;
    constexpr int NITEMS = N_IN + N_OUT + 2 * N_UP + 2 * N_DN + N_KV + N_Q + N_O + N_G;
    for (int it = gw; it < NITEMS; it += NGW) {
        int r = it;
        if (r < N_IN) { p0_transpose_item(A.in[I_WIN], 1024, 2560, (bf16*)(ws + WS_WIN), 0, A.in[I_GMIX], 0xffff, 1.f, scr, r, lane); continue; } r -= N_IN;
        if (r < N_OUT) { p0_transpose_item(A.in[I_WOUT], 1280, 1024, (bf16*)(ws + WS_WOUT), 0, nullptr, 0, 1.f, scr, r, lane); continue; } r -= N_OUT;
        if (r < N_UP) { p0_transpose_item(A.in[I_WUP], 1024, 4096, (bf16*)(ws + WS_WUP0), 0, A.in[I_GMLP], 0xffff, 1.f, scr, r, lane); continue; } r -= N_UP;
        if (r < N_UP) { p0_transpose_item(A.in[I_WUP] + (size_t)1024 * 4096, 1024, 4096, (bf16*)(ws + WS_WUP1), 0, A.in[I_GMLP] + 1024, 0xffff, 1.f, scr, r, lane); continue; } r -= N_UP;
        if (r < N_DN) { p0_transpose_item(A.in[I_WDN], 4096, 1024, (bf16*)(ws + WS_WDN0), 0, nullptr, 0, 1.f, scr, r, lane); continue; } r -= N_DN;
        if (r < N_DN) { p0_transpose_item(A.in[I_WDN] + (size_t)4096 * 1024, 4096, 1024, (bf16*)(ws + WS_WDN1), 0, nullptr, 0, 1.f, scr, r, lane); continue; } r -= N_DN;
        if (r < N_KV) { p0_transpose_item(A.in[I_WKV], 1024, 2048, (bf16*)(ws + WS_WKVQ), 0, A.in[I_GKV], 0xffff, 1.f, scr, r, lane); continue; } r -= N_KV;
        if (r < N_Q) { p0_transpose_item(A.in[I_WQ], 1024, 1024, (bf16*)(ws + WS_WKVQ), 2048, A.in[I_GMIX] + 1024, 0xffff, QSCALE, scr, r, lane); continue; } r -= N_Q;
        if (r < N_O) { p0_transpose_item(A.in[I_WO], 1024, 1024, (bf16*)(ws + WS_WO), 0, A.in[I_GSUB], 127, 1.0f - LAM_INIT, scr, r, lane); continue; } r -= N_O;
        { const int n = r >> 3, sub = r & 7;
          p0_transpose_item(A.in[I_WGR] + (size_t)n * 16384, 128, 128, (bf16*)(ws + WS_WG) + (size_t)n * 256 * 128, 0, nullptr, 0, 1.f, scr, sub, lane);
          p0_transpose_item(A.in[I_WGI] + (size_t)n * 16384, 128, 128, (bf16*)(ws + WS_WG) + (size_t)n * 256 * 128, 128, nullptr, 0, 1.f, scr, sub, lane); }
    }
    bf16* H0 = (bf16*)(ws + WS_H0); float* rs0 = (float*)(ws + WS_RS0);
    for (int row = gw; row < R_SAMP; row += 4 * NGW) {
        f32x4 v[4][4];
#pragma unroll
        for (int k = 0; k < 4; ++k) { const int rr = row + k * NGW < R_SAMP ? row + k * NGW : row; const f32x4* xr = (const f32x4*)(A.in[I_XP] + (size_t)rr * DM) + lane;
#pragma unroll
            for (int j = 0; j < 4; ++j) v[k][j] = xr[64 * j]; }
#pragma unroll
        for (int k = 0; k < 4; ++k) {
            const int rr = row + k * NGW;
            float sq = 0.f;
#pragma unroll
            for (int j = 0; j < 4; ++j) sq += (v[k][j].x * v[k][j].x + v[k][j].y * v[k][j].y) + (v[k][j].z * v[k][j].z + v[k][j].w * v[k][j].w);
            sq = wave_sum(sq);
            if (rr < R_SAMP) {
                v2u* o8 = (v2u*)(H0 + (size_t)rr * DM) + lane;
#pragma unroll
                for (int j = 0; j < 4; ++j) { v2u w; w.x = pk2(v[k][j].x, v[k][j].y); w.y = pk2(v[k][j].z, v[k][j].w); o8[64 * j] = w; }
                if (lane == 0) rs0[rr] = 1.0f / sqrtf(sq * (1.0f / DM) + EPS);
            }
        }
    }
    for (int row = R_SAMP + gw; row < MROWS; row += NGW) {
        if (row < R_PAD) {
            const float* src = row < R_META ? A.in[I_XS] + (size_t)(row - R_SAMP) * DM : A.in[I_META] + (size_t)(row - R_META) * DM;
            const float s = row_to_bf16(src, H0 + (size_t)row * DM, lane);
            if (lane == 0) rs0[row] = 1.0f / sqrtf(s * (1.0f / DM) + EPS);
        } else {
            v4u z = {0u, 0u, 0u, 0u}; v4u* o = (v4u*)(H0 + (size_t)row * DM) + lane; o[0] = z; o[64] = z;
            if (lane == 0) rs0[row] = 0.f;
        }
    }
    for (int j = gw; j < 8 * 1040; j += NGW) {
        const int b = j / 1040, r = j % 1040;
        const float* sk = r < 16 ? A.in[I_CMK] + (size_t)(b * 16 + r) * DM : A.in[I_CK] + (size_t)(b * 1024 + r - 16) * DM;
        const float* sv = r < 16 ? A.in[I_CMV] + (size_t)(b * 16 + r) * DM : A.in[I_CV] + (size_t)(b * 1024 + r - 16) * DM;
        (void)row_to_bf16(sk, (bf16*)(ws + WS_CKB) + (size_t)(b * 1072 + r) * DM, lane);
        (void)row_to_bf16(sv, (bf16*)(ws + WS_CVB) + (size_t)(b * 1072 + r) * DM, lane);
    }
    for (int i = gw; i < 27; i += NGW) {
        bf16* dst = (bf16*)(ws + WS_XR) + (size_t)(R_HALO_S + i) * DR;
        for (int c = lane; c < DR; c += 64) dst[c] = i < 24 ? (bf16)f2bf(A.in[I_SC][(size_t)i * DR + c]) : (bf16)0;
    }
    { float* z = (float*)(ws + WS_SSQ1); const int n = 4 * (int)(MiB / 4); for (int i = gw * 64 + lane; i < n; i += NGW * 64) z[i] = 0.f; }
    { float* z = (float*)(ws + WS_ACC); for (int i = gw * 64 + lane; i < 256 * DM; i += NGW * 64) z[i] = 0.f; }
    { float* lut = (float*)(ws + WS_LUT); for (int i = gw * 64 + lane; i < 8 * 192; i += NGW * 64) { const int h = i / 192, k = i % 192; lut[i] = A.in[I_RELB][t5_bucket(k - 128) * 8 + h] * LOG2E; } }
}

namespace rnn {
constexpr int RSX = 272;
constexpr int XC_OFF = 0, HS_OFF = 128 * RSX;
__device__ __forceinline__ void chain(const Args& A, LAS unsigned char* lds, int ch) {
    unsigned char* ws = A.ws;
    const int tid = otid(), lane = tid & 63, fr = lane & 15, fq = lane >> 4;
    const int w = __builtin_amdgcn_readfirstlane(tid >> 6);
    const bool samp = ch >= 160;
    const int b = samp ? (ch - 160) / 10 : ch / 10, n = samp ? (ch - 160) % 10 : ch % 10;
    const bf16* XR = (const bf16*)(ws + WS_XR); const bf16* GATE = (const bf16*)(ws + WS_GATE); bf16* Z = (bf16*)(ws + WS_Z);
    const bf16* wg = (const bf16*)(ws + WS_WG) + (size_t)n * 256 * 128;
    bf16x8 Br[4], Bi[4];
#pragma unroll
    for (int ks = 0; ks < 4; ++ks) { Br[ks] = *(const bf16x8*)(wg + (size_t)(16 * w + fr) * 128 + 32 * ks + 8 * fq); Bi[ks] = *(const bf16x8*)(wg + (size_t)(128 + 16 * w + fr) * 128 + 32 * ks + 8 * fq); }
    const int c = 128 * n + 16 * w + fr;
    const float nbr = -A.in[I_BGR][c] * LOG2E, nbi = -A.in[I_BGI][c] * LOG2E;
    const float sp = 8.0f * log1pf(expf(-A.in[I_LAM][c])) * LOG2E;
    float carry = samp ? A.in[I_SH][(size_t)b * DR + c] : 0.f;
    const int cgp = tid & 15, tg = tid >> 4;
    const int ccol = 128 * n + 8 * cgp;
    constexpr int CW_OFF = 2 * 128 * RSX;
    __syncthreads();
    for (int i = tid; i < 640; i += 512) { const int j = i >> 7, cc = i & 127; ((LAS float*)(lds + CW_OFF))[i] = j < 4 ? A.in[I_CONVW][(size_t)j * DR + 128 * n + cc] : A.in[I_CONVB][128 * n + cc]; }
    const int nseg = samp ? 1 : 33;
#define RNN_SEG(sg_) int row0, ntok, hrow; bool wz = true; \
        if (samp) { row0 = R_SAMP + 32 * b; ntok = 32; hrow = R_HALO_S + 3 * b; } \
        else if ((sg_) == 0) { row0 = R_META; ntok = 16; hrow = R_HALO_Z; wz = (b == 0); } \
        else { row0 = b * 4096 + 128 * ((sg_) - 1); ntok = 128; hrow = (sg_) == 1 ? R_META + 13 : row0 - 3; }
#define RNN_LOADX(sg_) do { RNN_SEG(sg_) (void)wz; if (4 * tg < ntok) { \
        _Pragma("unroll") for (int d = 0; d < 7; ++d) { const int tok = 4 * tg - 3 + d; const int grow = tok < 0 ? hrow + 3 + tok : row0 + tok; x[d] = *(const v4u*)(XR + (size_t)grow * DR + ccol); } } } while (0)
    v4u x[7];
#pragma unroll
    for (int d = 0; d < 7; ++d) x[d] = (v4u){0u, 0u, 0u, 0u};
    RNN_LOADX(0);
    __syncthreads();
    for (int sg = 0; sg < nseg; ++sg) {
        RNN_SEG(sg)
        const int nm = ntok >> 4;
        v4u gv[4];
#pragma unroll
        for (int j = 0; j < 4; ++j) gv[j] = (v4u){0u, 0u, 0u, 0u};
        if (wz && 4 * tg < ntok) {
#pragma unroll
            for (int j = 0; j < 4; ++j) gv[j] = *(const v4u*)(GATE + (size_t)(row0 + 4 * tg + j) * DR + ccol);
        }
        if (4 * tg < ntok) {
            f32x4 cw[4][2], cb[2];
#pragma unroll
            for (int j = 0; j < 4; ++j) { cw[j][0] = *(const LAS f32x4*)(lds + CW_OFF + (j * 128 + 8 * cgp) * 4); cw[j][1] = *(const LAS f32x4*)(lds + CW_OFF + (j * 128 + 8 * cgp + 4) * 4); }
            cb[0] = *(const LAS f32x4*)(lds + CW_OFF + (4 * 128 + 8 * cgp) * 4); cb[1] = *(const LAS f32x4*)(lds + CW_OFF + (4 * 128 + 8 * cgp + 4) * 4);
#pragma unroll
            for (int j = 0; j < 4; ++j) {
                f32x4 a0 = cb[0], a1 = cb[1];
#pragma unroll
                for (int d = 0; d < 4; ++d) { const v4u xv = x[j + d];
                    a0[0] += cw[d][0][0] * bflo(xv.x); a0[1] += cw[d][0][1] * bfhi(xv.x); a0[2] += cw[d][0][2] * bflo(xv.y); a0[3] += cw[d][0][3] * bfhi(xv.y);
                    a1[0] += cw[d][1][0] * bflo(xv.z); a1[1] += cw[d][1][1] * bfhi(xv.z); a1[2] += cw[d][1][2] * bflo(xv.w); a1[3] += cw[d][1][3] * bfhi(xv.w); }
                v4u o; o.x = pg8::cvt_pk_bf16(a0[0], a0[1]); o.y = pg8::cvt_pk_bf16(a0[2], a0[3]); o.z = pg8::cvt_pk_bf16(a1[0], a1[1]); o.w = pg8::cvt_pk_bf16(a1[2], a1[3]);
                *(LAS v4u*)(lds + XC_OFF + (4 * tg + j) * RSX + cgp * 16) = o;
            }
        }
        if (sg + 1 < nseg) RNN_LOADX(sg + 1);
        __syncthreads();
        f32x4 aR[8], aI[8];
#pragma unroll
        for (int m = 0; m < 8; ++m) {
            aR[m] = (f32x4){0.f, 0.f, 0.f, 0.f}; aI[m] = (f32x4){0.f, 0.f, 0.f, 0.f};
            if (m < nm) {
#pragma unroll
                for (int ks = 0; ks < 4; ++ks) {
                    const bf16x8 af = *(const LAS bf16x8*)(lds + XC_OFF + (16 * m + fr) * RSX + (32 * ks + 8 * fq) * 2);
                    aR[m] = __builtin_amdgcn_mfma_f32_16x16x32_bf16(af, Br[ks], aR[m], 0, 0, 0);
                    aI[m] = __builtin_amdgcn_mfma_f32_16x16x32_bf16(af, Bi[ks], aI[m], 0, 0, 0);
                }
            }
        }
#pragma unroll
        for (int m = 0; m < 8; ++m) {
            if (m < nm) {
                float P[4], S[4]; float Ap = 1.f, Sp = 0.f;
#pragma unroll
                for (int j = 0; j < 4; ++j) {
                    const int t = 16 * m + 4 * fq + j;
                    const float xcv = __uint_as_float((unsigned)(*(const LAS unsigned short*)(lds + XC_OFF + t * RSX + (16 * w + fr) * 2)) << 16);
                    const float r = __builtin_amdgcn_rcpf(1.f + __builtin_amdgcn_exp2f(__builtin_fmaf(aR[m][j], -LOG2E, nbr)));
                    const float ig = __builtin_amdgcn_rcpf(1.f + __builtin_amdgcn_exp2f(__builtin_fmaf(aI[m][j], -LOG2E, nbi)));
                    const float a = __builtin_amdgcn_exp2f(-sp * r);
                    const float uu = __builtin_amdgcn_sqrtf(__builtin_fmaf(-a, a, 1.0f)) * ig * xcv;
                    Sp = a * Sp + uu; Ap = Ap * a; P[j] = Ap; S[j] = Sp;
                }
                { const float A1 = __shfl_up(Ap, 16), U1 = __shfl_up(Sp, 16); if (fq >= 1) { Sp = Ap * U1 + Sp; Ap = Ap * A1; } }
                { const float A2 = __shfl_up(Ap, 32), U2 = __shfl_up(Sp, 32); if (fq >= 2) { Sp = Ap * U2 + Sp; Ap = Ap * A2; } }
                float Ae = __shfl_up(Ap, 16), Ue = __shfl_up(Sp, 16); if (fq == 0) { Ae = 1.f; Ue = 0.f; }
                const float hin = Ae * carry + Ue;
#pragma unroll
                for (int j = 0; j < 4; ++j) {
                    const int t = 16 * m + 4 * fq + j;
                    *(LAS unsigned short*)(lds + HS_OFF + t * RSX + (16 * w + fr) * 2) = (unsigned short)att::cvtpk(P[j] * hin + S[j], 0.f);
                }
                const float At = __shfl(Ap, 48 + fr), Ut = __shfl(Sp, 48 + fr);
                carry = At * carry + Ut;
            }
        }
        __syncthreads();
        if (wz && 4 * tg < ntok) {
#pragma unroll
            for (int j = 0; j < 4; ++j) {
                const int tok = 4 * tg + j; const size_t go = (size_t)(row0 + tok) * DR + ccol;
                const v4u hv = *(const LAS v4u*)(lds + HS_OFF + tok * RSX + cgp * 16); const v4u gvj = gv[j];
                v4u o; o.x = pg8::cvt_pk_bf16(bflo(hv.x) * bflo(gvj.x), bfhi(hv.x) * bfhi(gvj.x)); o.y = pg8::cvt_pk_bf16(bflo(hv.y) * bflo(gvj.y), bfhi(hv.y) * bfhi(gvj.y));
                o.z = pg8::cvt_pk_bf16(bflo(hv.z) * bflo(gvj.z), bfhi(hv.z) * bfhi(gvj.z)); o.w = pg8::cvt_pk_bf16(bflo(hv.w) * bflo(gvj.w), bfhi(hv.w) * bfhi(gvj.w));
                *(v4u*)(Z + go) = o;
            }
        }
    }
#undef RNN_SEG
#undef RNN_LOADX
    if (fq == 0) A.out[(samp ? OFF_SHS : OFF_SHP) + (size_t)b * DR + c] = carry;
    __syncthreads();
}
}

constexpr int LDS_BYTES = 147456;
#ifndef PHMASK
#define PHMASK 0xFFF
#endif
#ifndef PHREP
#define PHREP 0
#endif
#define PH(k) for (int rep_ = 0; rep_ < (((PHMASK >> (k)) & 1) ? 1 + ((PHREP >> (k)) & 1) : 0); ++rep_)
__global__ void __launch_bounds__(512) yoco_fwd(Args A) {
    extern __shared__ __attribute__((aligned(16))) unsigned char lds_raw[];
    LAS unsigned char* lds = (LAS unsigned char*)lds_raw;
    cg::grid_group grid = cg::this_grid();
    unsigned char* ws = A.ws;
    const int G = gridDim.x, bx = blockIdx.x;
    bf16* H0 = (bf16*)(ws + WS_H0); bf16* H1 = (bf16*)(ws + WS_H1); bf16* H2 = (bf16*)(ws + WS_H2); bf16* H3 = (bf16*)(ws + WS_H3);
    bf16* ACT = (bf16*)(ws + WS_ACT);
    float* SSQ1 = (float*)(ws + WS_SSQ1); float* SSQ2 = (float*)(ws + WS_SSQ2); float* SSQ3 = (float*)(ws + WS_SSQ3); float* SSQ4 = (float*)(ws + WS_SSQ4);

    unsigned* barw = (unsigned*)ws;
    if (bx == 0) for (int i = threadIdx.x; i < XCD_BAR_WORDS; i += 512) barw[i] = 0u;
    volatile LAS unsigned* bst = (volatile LAS unsigned*)(lds + LDS_BYTES - 64);
    if (threadIdx.x < 2) bst[threadIdx.x] = 0u;
    __syncthreads();
    PH(0) p0_prologue(A, lds);
    grid.sync();
    const XcdBarrier xbar = xcd_barrier_post(barw, bst);
    PH(1) { pg8::Gemm g{H0, (const bf16*)(ws + WS_WIN), MROWS, 2 * DR, DM}; pg8::StaticOrder S; S.init(MROWS, 2 * DR, G, bx);
      pg8::EpiIn E{(bf16*)(ws + WS_GATE), (bf16*)(ws + WS_XR), (const float*)(ws + WS_RS0), A.out};
      pg8::gemm_phase<pg8::EpiIn, pg8::StaticOrder, true, true>(lds, g, S, E); }
    xcd_barrier(xbar);
    PH(2) for (int ch = bx; ch < 240; ch += G) rnn::chain(A, lds, ch);
    xcd_barrier(xbar);
    PH(3) { pg8::Gemm g{(const bf16*)(ws + WS_Z), (const bf16*)(ws + WS_WOUT), MROWS, DM, DR}; pg8::StaticOrder S; S.init(MROWS, DM, G, bx);
      pg8::EpiRes<false> E{H0, H1, nullptr, SSQ1};
      pg8::gemm_phase<pg8::EpiRes<false>, pg8::StaticOrder, true, true>(lds, g, S, E); }
    xcd_barrier(xbar);
    PH(4) { pg8::Gemm g{H1, (const bf16*)(ws + WS_WUP0), MROWS, DFF, DM}; pg8::StaticOrder S; S.init(MROWS, DFF, G, bx);
      pg8::EpiUp E{ACT, SSQ1};
      pg8::gemm_phase<pg8::EpiUp, pg8::StaticOrder, true, true>(lds, g, S, E); }
    xcd_barrier(xbar);
    PH(5) { pg8::Gemm g{ACT, (const bf16*)(ws + WS_WDN0), R_SAMP, DM, DFF}; pg8::StaticOrder S; S.init(R_SAMP, DM, G, bx);
      pg8::EpiRes<false> E{H1, H2, nullptr, SSQ2};
      pg8::gemm_phase<pg8::EpiRes<false>, pg8::StaticOrder, true, true>(lds, g, S, E); }
    xcd_barrier(xbar);
    PH(6) {
        if (bx < 8) {
            pg8::Gemm g{ACT, (const bf16*)(ws + WS_WDN0), MROWS, DM, DFF}; pg8::TailOrder S{R_SAMP / 256, DM / 256, 8, bx};
            pg8::EpiRes<false> E{H1, H2, nullptr, SSQ2};
            pg8::gemm_phase<pg8::EpiRes<false>, pg8::TailOrder, true, true>(lds, g, S, E);
        } else {
            static_assert(WS_VB - WS_KB == WS_QB - WS_VB, "K|V|Q spacing");
            pg8::Gemm g{H2, (const bf16*)(ws + WS_WKVQ), R_SAMP, 3 * DM, DM}; pg8::StaticOrder S; S.init(R_SAMP, 3 * DM, G - 8, bx - 8);
            pg8::EpiKVQ E{SSQ2, (bf16*)(ws + WS_KB), (bf16*)(ws + WS_CKB), (WS_VB - WS_KB) / 2, (WS_CVB - WS_CKB) / 2, A.out};
            pg8::gemm_phase<pg8::EpiKVQ, pg8::StaticOrder, true, true>(lds, g, S, E);
        }
    }
    xcd_barrier(xbar);
    PH(6) { pg8::Gemm g{H2, (const bf16*)(ws + WS_WKVQ), MROWS, 3 * DM, DM}; pg8::TailOrder S{R_SAMP / 256, 3 * DM / 256, 24, bx};
      pg8::EpiKVQ E{SSQ2, (bf16*)(ws + WS_KB), (bf16*)(ws + WS_CKB), (WS_VB - WS_KB) / 2, (WS_CVB - WS_CKB) / 2, A.out};
      pg8::gemm_phase<pg8::EpiKVQ, pg8::TailOrder, true, true>(lds, g, S, E); }
    xcd_barrier(xbar);
    PH(7) {
        const int lane = otid() & 63;
        const float d1 = wave_sum(A.in[I_LQ1][lane] * A.in[I_LK1][lane]), d2 = wave_sum(A.in[I_LQ2][lane] * A.in[I_LK2][lane]);
        const float lam = expf(d1) - expf(d2) + LAM_INIT;
        const bf16* KB = (const bf16*)(ws + WS_KB); const bf16* VB = (const bf16*)(ws + WS_VB); const bf16* QB = (const bf16*)(ws + WS_QB); bf16* OB = (bf16*)(ws + WS_OB);
        const float* lutg = (const float*)(ws + WS_LUT);
        const int vcu = (G % 8 == 0) ? (bx % 8) * (G / 8) + bx / 8 : bx;
        const bf16* CK = (const bf16*)(ws + WS_CKB); const bf16* CV = (const bf16*)(ws + WS_CVB);
#ifndef ATT_ABL
#define ATT_ABL -1
#endif
#pragma unroll 1
        for (int pass = 0; pass < (ATT_ABL >= 0 ? 2 : 1); ++pass)
#pragma unroll 1
        for (int i = 0;; ++i) {
            const int abl = pass ? ATT_ABL : 0;
            const int p = vcu + G * (i >> 1), k = i & 1;
            if (p >= 2048 + 64) break;
            const bf16 *Qh, *kme, *vme, *kma, *vma; bf16* Oh; int nqw, qpos0, nmain, h;
            if (p < 2048) {
                const int bh = p >> 4, s = p & 15, b = bh >> 3; h = bh & 7;
                const int qb = k ? 31 - s : s; const size_t r0 = (size_t)b * 4096 + 128 * qb;
                Qh = QB + r0 * DM + h * 128; Oh = OB + r0 * DM + h * 128; nqw = 4; qpos0 = 128 * qb; nmain = 4096;
                kme = KB + (size_t)R_META * DM + h * 128; vme = VB + (size_t)R_META * DM + h * 128;
                kma = KB + (size_t)b * 4096 * DM + h * 128; vma = VB + (size_t)b * 4096 * DM + h * 128;
            } else {
                if (k) continue;
                const int u = p - 2048, b = u >> 3; h = u & 7; const size_t r0 = (size_t)R_SAMP + 32 * b;
                Qh = QB + r0 * DM + h * 128; Oh = OB + r0 * DM + h * 128; nqw = 1; qpos0 = 1024; nmain = 1056;
                kme = CK + (size_t)b * 1072 * DM + h * 128; vme = CV + (size_t)b * 1072 * DM + h * 128;
                kma = kme + (size_t)16 * DM; vma = vme + (size_t)16 * DM;
            }
            if (pass) Oh = (bf16*)(ws + WS_H0) + (Oh - OB);
            att::attn_unit(lds, Qh, Oh, nqw, qpos0, kme, vme, kma, vma, nmain, lutg + h * 192, lutg[h * 192], lam, abl, nqw == 1);
        }
    }
    xcd_barrier(xbar);
    PH(8) { pg8::Gemm g{(const bf16*)(ws + WS_OB), (const bf16*)(ws + WS_WO), MROWS1, DM, DM}; pg8::StaticOrder S; S.init(MROWS1, DM, G, bx);
      pg8::EpiRes<false> E{H2, H3, nullptr, SSQ3};
      pg8::gemm_phase<pg8::EpiRes<false>, pg8::StaticOrder, true, true>(lds, g, S, E); }
    xcd_barrier(xbar);
    PH(9) { pg8::Gemm g{H3, (const bf16*)(ws + WS_WUP1), MROWS1, DFF, DM}; pg8::StaticOrder S; S.init(MROWS1, DFF, G, bx);
      pg8::EpiUp E{ACT, SSQ3};
      pg8::gemm_phase<pg8::EpiUp, pg8::StaticOrder, true, true>(lds, g, S, E); }
    xcd_barrier(xbar);
    PH(10) { pg8::Gemm g{ACT, (const bf16*)(ws + WS_WDN1), R_SAMP, DM, DFF}; pg8::StaticOrder S; S.init(R_SAMP, DM, G, bx);
      pg8::EpiRes<false> E{H3, H1, nullptr, SSQ4};
      pg8::gemm_phase<pg8::EpiRes<false>, pg8::StaticOrder, true, true>(lds, g, S, E); }
    xcd_barrier(xbar);
#define FINAL_NORM(ROW_BEGIN, ROW_END, WORKER, NWORKERS) do { \
        const int tid_ = otid(), lane = tid_ & 63, wave = __builtin_amdgcn_readfirstlane(tid_ >> 6); \
        const f32x4* gf = (const f32x4*)A.in[I_GF] + 2 * lane; \
        f32x4 gv[4]; \
        _Pragma("unroll") for (int j = 0; j < 2; ++j) { gv[2 * j] = gf[128 * j]; gv[2 * j + 1] = gf[128 * j + 1]; } \
        for (int row = (ROW_BEGIN) + (WORKER) * 8 + wave; row < (ROW_END); row += (NWORKERS) * 8) { \
            const float s = 1.0f / sqrtf(SSQ4[row] * (1.0f / DM) + EPS); \
            const v4u* hp = (const v4u*)(H1 + (size_t)row * DM) + lane;        \
            f32x4* y = (f32x4*)(A.out + OFF_Y + (size_t)row * DM) + 2 * lane; \
            _Pragma("unroll") for (int j = 0; j < 2; ++j) { \
                const v4u h = hp[64 * j]; \
                f32x4 v0 = {bflo(h.x), bfhi(h.x), bflo(h.y), bfhi(h.y)}, v1 = {bflo(h.z), bfhi(h.z), bflo(h.w), bfhi(h.w)}; \
                __builtin_nontemporal_store(v0 * s * gv[2 * j], &y[128 * j]); __builtin_nontemporal_store(v1 * s * gv[2 * j + 1], &y[128 * j + 1]); } \
        } } while (0)
    PH(11) {
        if (bx < 16) {
            pg8::Gemm g{ACT, (const bf16*)(ws + WS_WDN1), MROWS1, DM, 1024, DFF}; pg8::SplitKOrder S{R_SAMP / 256, DM / 256, 16, 1024 * 2, bx};
            pg8::EpiAcc E{(float*)(ws + WS_ACC), R_SAMP};
            pg8::gemm_phase<pg8::EpiAcc, pg8::SplitKOrder, true, true>(lds, g, S, E);
        } else FINAL_NORM(0, R_SAMP, bx - 16, G - 16);
    }
    xcd_barrier(xbar);
    PH(11) {
        const int tid_ = otid(), lane = tid_ & 63, wave = __builtin_amdgcn_readfirstlane(tid_ >> 6);
        const f32x4* gf = (const f32x4*)A.in[I_GF] + 2 * lane;
        for (int row = R_SAMP + bx * 8 + wave; row < MROWS1; row += G * 8) {
            const v4u* hp = (const v4u*)(H3 + (size_t)row * DM) + lane;
            const f32x4* ap = (const f32x4*)((const float*)(ws + WS_ACC) + (size_t)(row - R_SAMP) * DM) + 2 * lane;
            f32x4 v[4]; float sq = 0.f;
#pragma unroll
            for (int j = 0; j < 2; ++j) {
                const v4u h = hp[64 * j];
                v[2 * j] = ap[128 * j] + (f32x4){bflo(h.x), bfhi(h.x), bflo(h.y), bfhi(h.y)}; v[2 * j + 1] = ap[128 * j + 1] + (f32x4){bflo(h.z), bfhi(h.z), bflo(h.w), bfhi(h.w)};
            }
#pragma unroll
            for (int j = 0; j < 4; ++j) sq += (v[j].x * v[j].x + v[j].y * v[j].y) + (v[j].z * v[j].z + v[j].w * v[j].w);
            const float s = 1.0f / sqrtf(wave_sum(sq) * (1.0f / DM) + EPS);
            f32x4* y = (f32x4*)(A.out + OFF_Y + (size_t)row * DM) + 2 * lane;
#pragma unroll
            for (int j = 0; j < 2; ++j) { y[128 * j] = v[2 * j] * s * gf[128 * j]; y[128 * j + 1] = v[2 * j + 1] * s * gf[128 * j + 1]; }
        }
    }
#undef FINAL_NORM
}

extern "C" void kernel_launch(void* const* d_in, const int* in_sizes, int n_in, void* d_out, int out_size, void* d_ws, size_t ws_size, hipStream_t stream) {
    static int grid = 0;
    if (grid == 0) {
        if (n_in != 33 || ws_size < WS_END) { fprintf(stderr, "kernel_launch: unexpected inputs (n_in %d, ws %zu)\n", n_in, ws_size); grid = -1; return; }
        int dev = 0, cus = 0, per_cu = 0;
        (void)hipGetDevice(&dev);
        (void)hipDeviceGetAttribute(&cus, hipDeviceAttributeMultiprocessorCount, dev);
        (void)hipFuncSetAttribute((const void*)yoco_fwd, hipFuncAttributeMaxDynamicSharedMemorySize, LDS_BYTES);
        (void)hipOccupancyMaxActiveBlocksPerMultiprocessor(&per_cu, (const void*)yoco_fwd, 512, LDS_BYTES);
        if (per_cu < 1) per_cu = 1;
        grid = cus * per_cu;
        (void)hipGetLastError();
    }
    if (grid < 0) return;
    Args a{};
    for (int i = 0; i < 33; ++i) a.in[i] = (const float*)d_in[i];
    a.out = (float*)d_out; a.ws = (unsigned char*)d_ws;
    void* args[] = {&a};
    hipError_t e = hipLaunchCooperativeKernel((const void*)yoco_fwd, dim3(grid), dim3(512), args, LDS_BYTES, stream);
    if (e != hipSuccess) fprintf(stderr, "cooperative launch failed: %s (grid %d)\n", hipGetErrorString(e), grid);
}
```

```cpp
#include <hip/hip_runtime.h>
#include <hip/hip_cooperative_groups.h>
#include <cstdio>
#include <cstdint>
namespace cg = cooperative_groups;

constexpr int R_SAMP = 65536, R_META = 65792, R_PAD = 65808, MROWS = 66048, MROWS1 = 65792;
constexpr int R_HALO_S = 65808;
constexpr int R_HALO_Z = 65832;
constexpr int DM = 1024, DR = 1280, DFF = 4096;
constexpr size_t OFF_Y = 0, OFF_SHP = 67371008, OFF_SCP = 67391488, OFF_MK = 67452928, OFF_MV = 67715072, OFF_KP = 67977216,
                 OFF_VP = 135086080, OFF_SHS = 202194944, OFF_SCS = 202205184, OFF_KS = 202235904, OFF_VS = 202498048;
constexpr float EPS = 1e-6f, LOG2E = 1.4426950408889634f;
constexpr float LAM_INIT = 0.35550906759f;
constexpr float QSCALE = 0.125f * LOG2E;

__device__ __forceinline__ int otid() { int t = threadIdx.x; asm volatile("" : "+v"(t)); return t; }

namespace pg8 {
#define PG8_LAS __attribute__((address_space(3)))
typedef unsigned short bf16_t;
typedef short bf16x8 __attribute__((ext_vector_type(8)));
typedef float f32x4 __attribute__((ext_vector_type(4)));
typedef unsigned u32x4 __attribute__((ext_vector_type(4)));
constexpr int BM = 256, BK = 64, HALF = 128, HTB = HALF * BK * 2  , STAGE_BYTES = 8 * HTB, NXCD = 8, WGM = 8;

__host__ __device__ __forceinline__ int lds_byte(int r, int c) { const int st = (r >> 4) * 2 + (c >> 5), rr = r & 15, cc = c & 31, ob = rr * 64 + cc * 2; return st * 1024 + (ob ^ (((ob >> 9) & 1) << 5)); }
__host__ __device__ __forceinline__ void stage_rc(int b, int& R, int& C) { const int st = b / 1024, sb = b % 1024, swz = sb ^ (((sb >> 9) & 1) << 5); R = (st >> 1) * 16 + swz / 64; C = (st & 1) * 32 + (swz % 64) / 2; }
__host__ __device__ __forceinline__ int perm32(int rho) { const int n = rho >> 4, i = rho & 15; return 8 * (i >> 2) + 4 * n + (i & 3); }

struct Unit { int pm, pn, ko; };
struct Gemm { const bf16_t* A; const bf16_t* Bt; int M, N, K, ld; };

struct StaticOrder {
    int nM, nN, nwg, G, c;
    __host__ __device__ void init(int M, int N, int G_, int c_) { nM = M / BM; nN = N / BM; nwg = nM * nN; G = G_; c = c_; }
    __host__ __device__ bool next(int i, Unit& u) const {
        const long L = (long)i * G + c; if (L >= nwg) return false;
        int wgid = (int)L; { const int q = nwg / NXCD, r = nwg % NXCD, xcd = wgid % NXCD, off = wgid / NXCD; wgid = (xcd < r ? xcd * (q + 1) : r * (q + 1) + (xcd - r) * q) + off; }
        const int nig = WGM * nN, gid = wgid / nig, fm = gid * WGM, gsz = (nM - fm) < WGM ? (nM - fm) : WGM;
        u.pm = fm + ((wgid % nig) % gsz); u.pn = (wgid % nig) / gsz; u.ko = 0; return true;
    }
    __device__ __forceinline__ void a_ready(const Unit&) const {}
    __device__ __forceinline__ void done(const Unit&) const {}
};

__device__ __forceinline__ unsigned cvt_pk_bf16(float lo, float hi) { unsigned r; asm volatile("v_cvt_pk_bf16_f32 %0, %1, %2" : "=v"(r) : "v"(lo), "v"(hi)); return r; }
typedef float f32x2 __attribute__((ext_vector_type(2)));

__device__ __forceinline__ float bf_lo(unsigned w) { return __uint_as_float(w << 16); }
__device__ __forceinline__ float bf_hi(unsigned w) { return __uint_as_float(w & 0xffff0000u); }
__device__ __forceinline__ float gelu_tanh(float x) {
    const float u = 0.7978845608f * (x + 0.044715f * x * x * x);
    return x * __builtin_amdgcn_rcpf(1.f + __builtin_amdgcn_exp2f(-2.885390082f * u));
}
typedef float pk_f32x2 __attribute__((ext_vector_type(2))); typedef __bf16 pk_bf16x2 __attribute__((ext_vector_type(2)));
__device__ __forceinline__ unsigned pkbf(float lo, float hi) { pk_f32x2 v = {lo, hi}; pk_bf16x2 r = __builtin_convertvector(v, pk_bf16x2); return __builtin_bit_cast(unsigned, r); }
__device__ __forceinline__ u32x4 pack8(const f32x4 v0, const f32x4 v1) {
    u32x4 w; w.x = pkbf(v0[0], v0[1]); w.y = pkbf(v0[2], v0[3]); w.z = pkbf(v1[0], v1[1]); w.w = pkbf(v1[2], v1[3]); return w;
}
struct EpiIn {
    static constexpr bool PERM = true, AFTER_DRAIN = false;
    bf16_t* gate; bf16_t* xr; const float* rs; float* out;
    __device__ __forceinline__ void operator()(const f32x4 (&acc)[2][2][4][2], const Unit& u, int wr, int wc, int fr, int fq) const {
        const bool isgate = u.pn < 5;
        const int colt = (isgate ? u.pn : u.pn - 5) * BM + wc * 32 + 8 * fq;
        bf16_t* base = isgate ? gate : xr;
        float sc[2][4];
#pragma unroll
        for (int ai = 0; ai < 2; ++ai)
#pragma unroll
            for (int m = 0; m < 4; ++m) sc[ai][m] = rs[u.pm * BM + ai * HALF + wr * 64 + m * 16 + fr];
#pragma unroll
        for (int ai = 0; ai < 2; ++ai)
#pragma unroll
            for (int m = 0; m < 4; ++m) {
                const int row = u.pm * BM + ai * HALF + wr * 64 + m * 16 + fr;
                const float s = sc[ai][m];
                float* sdst = nullptr;
                if (!isgate) {
                    if (row < R_SAMP) { const int t = row & 4095; if (t >= 4093) sdst = out + OFF_SCP + (size_t)((row >> 12) * 3 + (t - 4093)) * DR; }
                    else if (row < R_META) { const int q = row - R_SAMP, t = q & 31; if (t >= 29) sdst = out + OFF_SCS + (size_t)((q >> 5) * 3 + (t - 29)) * DR; }
                }
                const bool ok = isgate || row < R_PAD;
#pragma unroll
                for (int bj = 0; bj < 2; ++bj) {
                    f32x4 v0 = acc[ai][bj][m][0] * s, v1 = acc[ai][bj][m][1] * s;
                    const int col = colt + bj * HALF;
                    if (isgate) {
#pragma unroll
                        for (int e = 0; e < 4; ++e) { v0[e] = gelu_tanh(v0[e]); v1[e] = gelu_tanh(v1[e]); }
                    }
                    if (ok) *(u32x4*)(base + (size_t)row * DR + col) = pack8(v0, v1);
                    if (sdst) { *(f32x4*)(sdst + col) = v0; *(f32x4*)(sdst + col + 4) = v1; }
                }
            }
    }
};
template <bool F32OUT> struct EpiRes {
    static constexpr bool PERM = true, AFTER_DRAIN = false;
    const bf16_t* base; bf16_t* outb; float* outf; float* ssq;
    __device__ __forceinline__ void operator()(const f32x4 (&acc)[2][2][4][2], const Unit& u, int wr, int wc, int fr, int fq) const {
        const int colt = u.pn * BM + wc * 32 + 8 * fq;
        const size_t off0 = (size_t)(u.pm * BM + wr * 64 + fr) * DM + colt;
        u32x4 rb[8][2];
#pragma unroll
        for (int i = 0; i < 4; ++i)
#pragma unroll
            for (int bj = 0; bj < 2; ++bj) rb[i][bj] = *(const u32x4*)(base + off0 + (size_t)((i >> 2) * HALF + (i & 3) * 16) * DM + bj * HALF);
#pragma unroll
        for (int i = 0; i < 8; ++i) {
            const int ai = i >> 2, m = i & 3;
            if (i + 4 < 8) {
#pragma unroll
                for (int bj = 0; bj < 2; ++bj) rb[i + 4][bj] = *(const u32x4*)(base + off0 + (size_t)(((i + 4) >> 2) * HALF + ((i + 4) & 3) * 16) * DM + bj * HALF);
            }
            const int row = u.pm * BM + ai * HALF + wr * 64 + m * 16 + fr;
            const size_t off = off0 + (size_t)(ai * HALF + m * 16) * DM;
            float q = 0.f;
#pragma unroll
            for (int bj = 0; bj < 2; ++bj) {
                const u32x4 b = rb[i][bj];
                f32x4 v0 = acc[ai][bj][m][0], v1 = acc[ai][bj][m][1];
                v0[0] += bf_lo(b.x); v0[1] += bf_hi(b.x); v0[2] += bf_lo(b.y); v0[3] += bf_hi(b.y);
                v1[0] += bf_lo(b.z); v1[1] += bf_hi(b.z); v1[2] += bf_lo(b.w); v1[3] += bf_hi(b.w);
                q += (v0[0] * v0[0] + v0[1] * v0[1]) + (v0[2] * v0[2] + v0[3] * v0[3]) + (v1[0] * v1[0] + v1[1] * v1[1]) + (v1[2] * v1[2] + v1[3] * v1[3]);
                if (F32OUT) { *(f32x4*)(outf + off + bj * HALF) = v0; *(f32x4*)(outf + off + bj * HALF + 4) = v1; }
                else *(u32x4*)(outb + off + bj * HALF) = pack8(v0, v1);
            }
            q += __shfl_xor(q, 16); q += __shfl_xor(q, 32);
            if (fq == 0) __hip_atomic_fetch_add(ssq + row, q, __ATOMIC_RELAXED, __HIP_MEMORY_SCOPE_AGENT);
        }
    }
};
struct EpiUp {
    static constexpr bool PERM = true, AFTER_DRAIN = false;
    bf16_t* out; const float* ssq;
    __device__ __forceinline__ void operator()(const f32x4 (&acc)[2][2][4][2], const Unit& u, int wr, int wc, int fr, int fq) const {
        const int colt = u.pn * BM + wc * 32 + 8 * fq;
        float sc[2][4];
#pragma unroll
        for (int ai = 0; ai < 2; ++ai)
#pragma unroll
            for (int m = 0; m < 4; ++m) sc[ai][m] = ssq[u.pm * BM + ai * HALF + wr * 64 + m * 16 + fr];
#pragma unroll
        for (int ai = 0; ai < 2; ++ai)
#pragma unroll
            for (int m = 0; m < 4; ++m) {
                const int row = u.pm * BM + ai * HALF + wr * 64 + m * 16 + fr;
                const float s = __builtin_amdgcn_rsqf(sc[ai][m] * (1.0f / DM) + EPS);
#pragma unroll
                for (int bj = 0; bj < 2; ++bj) {
                    f32x4 v0 = acc[ai][bj][m][0] * s, v1 = acc[ai][bj][m][1] * s;
#pragma unroll
                    for (int e = 0; e < 4; ++e) { const float a = fmaxf(v0[e], 0.f), b = fmaxf(v1[e], 0.f); v0[e] = a * a; v1[e] = b * b; }
                    *(u32x4*)(out + (size_t)row * DFF + colt + bj * HALF) = pack8(v0, v1);
                }
            }
    }
};
struct EpiKVQ {
    static constexpr bool PERM = true, AFTER_DRAIN = false;
    const float* ssq; bf16_t *kb, *ckb; size_t bstride, cstride; float* out;
    __device__ __forceinline__ void operator()(const f32x4 (&acc)[2][2][4][2], const Unit& u, int wr, int wc, int fr, int fq) const {
        const int t = u.pn >> 2;
        const int colt = (u.pn & 3) * BM + wc * 32 + 8 * fq;
        bf16_t* bb = kb + (size_t)t * bstride;
        bf16_t* cb = ckb + (size_t)t * cstride;
        float* o_main = out + OFF_KP + (size_t)t * (OFF_VP - OFF_KP);
        float* o_samp = out + OFF_KS + (size_t)t * (OFF_VS - OFF_KS);
        float* o_meta = out + OFF_MK + (size_t)t * (OFF_MV - OFF_MK);
        float sc[2][4];
#pragma unroll
        for (int ai = 0; ai < 2; ++ai)
#pragma unroll
            for (int m = 0; m < 4; ++m) sc[ai][m] = ssq[u.pm * BM + ai * HALF + wr * 64 + m * 16 + fr];
#pragma unroll
        for (int ai = 0; ai < 2; ++ai)
#pragma unroll
            for (int m = 0; m < 4; ++m) {
                const int row = u.pm * BM + ai * HALF + wr * 64 + m * 16 + fr;
                const float s = __builtin_amdgcn_rsqf(sc[ai][m] * (1.0f / DM) + EPS);
#pragma unroll
                for (int bj = 0; bj < 2; ++bj) {
                    const f32x4 v0 = acc[ai][bj][m][0] * s, v1 = acc[ai][bj][m][1] * s;
                    const int col = colt + bj * HALF;
                    const u32x4 pk = pack8(v0, v1);
                    *(u32x4*)(bb + (size_t)row * DM + col) = pk;
                    if (t < 2) {
                        if (row < R_SAMP) { float* d = o_main + (size_t)row * DM + col; __builtin_nontemporal_store(v0, (f32x4*)d); __builtin_nontemporal_store(v1, (f32x4*)(d + 4)); }
                        else if (row < R_META) {
                            const int q = row - R_SAMP; float* d = o_samp + (size_t)q * DM + col; *(f32x4*)d = v0; *(f32x4*)(d + 4) = v1;
                            *(u32x4*)(cb + ((size_t)(q >> 5) * 1072 + 1040 + (q & 31)) * DM + col) = pk;
                        } else if (row < R_PAD) {
                            const int mm = row - R_META;
                            _Pragma("unroll 1") for (int b = 0; b < 16; ++b) { float* d = o_meta + (size_t)(b * 16 + mm) * DM + col; *(f32x4*)d = v0; *(f32x4*)(d + 4) = v1; }
                        }
                    }
                }
            }
    }
};

struct TailOrder {
    int pm0, nN, ntile, c;
    __host__ __device__ bool next(int i, Unit& u) const { if (i != 0 || c < 0 || c >= ntile) return false; u.pm = pm0 + c / nN; u.pn = c % nN; u.ko = 0; return true; }
    __device__ __forceinline__ void a_ready(const Unit&) const {}
    __device__ __forceinline__ void done(const Unit&) const {}
};
struct SplitKOrder {
    int pm0, nN, nunit, kbytes, c;
    __host__ __device__ bool next(int i, Unit& u) const { if (i != 0 || c < 0 || c >= nunit) return false; const int t = c >> 2; u.pm = pm0 + t / nN; u.pn = t % nN; u.ko = (c & 3) * kbytes; return true; }
    __device__ __forceinline__ void a_ready(const Unit&) const {}
    __device__ __forceinline__ void done(const Unit&) const {}
};
struct EpiAcc {
    static constexpr bool PERM = true, AFTER_DRAIN = false;
    float* accf; int row0;
    __device__ __forceinline__ void operator()(const f32x4 (&acc)[2][2][4][2], const Unit& u, int wr, int wc, int fr, int fq) const {
        const int colt = u.pn * BM + wc * 32 + 8 * fq;
#pragma unroll
        for (int ai = 0; ai < 2; ++ai)
#pragma unroll
            for (int m = 0; m < 4; ++m) {
                const int row = u.pm * BM + ai * HALF + wr * 64 + m * 16 + fr;
#pragma unroll
                for (int bj = 0; bj < 2; ++bj) {
                    float* d = accf + (size_t)(row - row0) * DM + colt + bj * HALF;
#pragma unroll
                    for (int e = 0; e < 4; ++e) { __hip_atomic_fetch_add(d + e, acc[ai][bj][m][0][e], __ATOMIC_RELAXED, __HIP_MEMORY_SCOPE_AGENT); __hip_atomic_fetch_add(d + 4 + e, acc[ai][bj][m][1][e], __ATOMIC_RELAXED, __HIP_MEMORY_SCOPE_AGENT); }
                }
            }
    }
};
template <class Epi, class Sched, bool ALIGN_EPI = false, bool SP2 = false>
__device__ __forceinline__ void gemm_phase(PG8_LAS unsigned char* lds, const Gemm g, const Sched& S, const Epi& E) {
    const int tid = otid(), wid = __builtin_amdgcn_readfirstlane(tid >> 6), lane = tid & 63, wr = wid >> 2, wc = wid & 3, fr = lane & 15, fq = lane >> 4;
    const int K = g.ld ? g.ld : g.K, nt = g.K / BK;
    unsigned voffA[2], voffB[2];
#pragma unroll
    for (int i = 0; i < 2; ++i) { int R, C; stage_rc(tid * 16 + i * 8192, R, C); const int Rb = Epi::PERM ? ((R & ~31) + perm32(R & 31)) : R;
        voffA[i] = (unsigned)(R * K + C) * 2u; voffB[i] = (unsigned)(Rb * K + C) * 2u; }
    const size_t kstep = (size_t)(BK * 2);
    const size_t hstep = (size_t)HALF * K * 2;
    const size_t tstep = 2 * hstep;
    const unsigned ldsw = (unsigned)wid * 1024u;
    const int aoff = lds_byte(wr * 64 + fr, fq * 8), boff = lds_byte(wc * 32 + fr, fq * 8);
#define PG8_SA(b, h) (((b) * 2 + (h)) * HTB)
#define PG8_SB(b, h) ((4 + (b) * 2 + (h)) * HTB)
#define PG8_STAGE(bufoff, gbase, voff) do { _Pragma("unroll") for (int _i = 0; _i < 2; ++_i) \
        __builtin_amdgcn_global_load_lds((const unsigned*)((const char*)(gbase) + (voff)[_i]), (PG8_LAS unsigned*)(lds + (bufoff) + ldsw + _i * 8192), 16, 0, 0); } while (0)
#define PG8_LDA(dst, b, h) do { _Pragma("unroll") for (int m = 0; m < 4; ++m) _Pragma("unroll") for (int k = 0; k < 2; ++k) dst[m][k] = *(const PG8_LAS bf16x8*)(lds + PG8_SA(b, h) + aoff + m * 2048 + k * 1024); } while (0)
#define PG8_LDB(dst, b, h) do { _Pragma("unroll") for (int n = 0; n < 2; ++n) _Pragma("unroll") for (int k = 0; k < 2; ++k) dst[n][k] = *(const PG8_LAS bf16x8*)(lds + PG8_SB(b, h) + boff + n * 2048 + k * 1024); } while (0)
#define PG8_MMA(ai, bj, At, Bt) do { __builtin_amdgcn_s_setprio(1); _Pragma("unroll") for (int m = 0; m < 4; ++m) _Pragma("unroll") for (int n = 0; n < 2; ++n) _Pragma("unroll") for (int k = 0; k < 2; ++k) \
        acc[ai][bj][m][n] = __builtin_amdgcn_mfma_f32_16x16x32_bf16(Bt[n][k], At[m][k], acc[ai][bj][m][n], 0, 0, 0); __builtin_amdgcn_s_setprio(0); } while (0)
#define PG8_WAIT_V(n) asm volatile("s_waitcnt vmcnt(" #n ")" ::: "memory")
#define PG8_WAIT_L(n) asm volatile("s_waitcnt lgkmcnt(" #n ")" ::: "memory")
#define PG8_BAR __builtin_amdgcn_s_barrier()
#define PG8_SCHED __builtin_amdgcn_sched_barrier(0)
    Unit cur, nxt; int ui = 0;
    if (!S.next(0, cur)) return;
    f32x4 acc[2][2][4][2];
#pragma unroll
    for (int a = 0; a < 2; ++a)
#pragma unroll
        for (int b = 0; b < 2; ++b)
#pragma unroll
            for (int m = 0; m < 4; ++m)
#pragma unroll
                for (int n = 0; n < 2; ++n) acc[a][b][m][n] = (f32x4){0.f, 0.f, 0.f, 0.f};
    bf16x8 At[4][2], B0[2][2], B1[2][2];
    const char* cA = (const char*)g.A + (size_t)cur.pm * tstep + cur.ko; const char* cB = (const char*)g.Bt + (size_t)cur.pn * tstep + cur.ko;
    S.a_ready(cur);
    if constexpr (SP2) {
        PG8_STAGE(PG8_SB(0, 0), cB, voffB); PG8_STAGE(PG8_SB(0, 1), cB + hstep, voffB); PG8_STAGE(PG8_SA(0, 0), cA, voffA); PG8_STAGE(PG8_SA(0, 1), cA + hstep, voffA);
        if (wr == 1) PG8_BAR;
        PG8_WAIT_V(2); PG8_BAR;
        PG8_STAGE(PG8_SB(1, 0), cB + kstep, voffB); PG8_STAGE(PG8_SA(1, 0), cA + kstep, voffA); PG8_STAGE(PG8_SB(1, 1), cB + hstep + kstep, voffB);
        PG8_WAIT_V(6); PG8_BAR;
    } else {
        PG8_STAGE(PG8_SB(0, 0), cB, voffB); PG8_STAGE(PG8_SA(0, 0), cA, voffA); PG8_STAGE(PG8_SB(0, 1), cB + hstep, voffB); PG8_STAGE(PG8_SA(0, 1), cA + hstep, voffA);
        if (wr == 1) PG8_BAR;
        PG8_WAIT_V(4); PG8_BAR;
        PG8_STAGE(PG8_SB(1, 0), cB + kstep, voffB); PG8_STAGE(PG8_SA(1, 0), cA + kstep, voffA); PG8_STAGE(PG8_SB(1, 1), cB + hstep + kstep, voffB);
        PG8_WAIT_V(6); PG8_BAR;
    }
    for (;;) {
        const bool has_next = S.next(ui + 1, nxt);
        const char* nA = has_next ? (const char*)g.A + (size_t)nxt.pm * tstep + nxt.ko : cA; const char* nB = has_next ? (const char*)g.Bt + (size_t)nxt.pn * tstep + nxt.ko : cB;
        for (int t = 0; t < nt; t += 2) {
            const bool last = (t == nt - 2);
            const char* a1 = cA + (size_t)(t + 1) * kstep;
            const char* a2 = last ? nA : cA + (size_t)(t + 2) * kstep; const char* b2 = last ? nB : cB + (size_t)(t + 2) * kstep;
            const char* a3 = a2 + kstep; const char* b3 = b2 + kstep;
            if (last && has_next) S.a_ready(nxt);
            if constexpr (SP2) {
            PG8_LDB(B0, 0, 0); PG8_LDB(B1, 0, 1); PG8_SCHED; PG8_LDA(At, 0, 0); PG8_STAGE(PG8_SA(1, 1), a1 + hstep, voffA);
            PG8_WAIT_V(8); PG8_WAIT_L(0); PG8_BAR; PG8_MMA(0, 0, At, B0); PG8_MMA(0, 1, At, B1); PG8_BAR; PG8_SCHED;
            PG8_LDA(At, 0, 1); PG8_STAGE(PG8_SB(0, 0), b2, voffB); PG8_STAGE(PG8_SB(0, 1), b2 + hstep, voffB); PG8_STAGE(PG8_SA(0, 0), a2, voffA);
            PG8_WAIT_V(8); PG8_WAIT_L(0); PG8_BAR; PG8_MMA(1, 0, At, B0); PG8_MMA(1, 1, At, B1); PG8_BAR; PG8_SCHED;
            PG8_LDB(B0, 1, 0); PG8_LDB(B1, 1, 1); PG8_SCHED; PG8_LDA(At, 1, 0); PG8_STAGE(PG8_SA(0, 1), a2 + hstep, voffA);
            PG8_WAIT_V(8); PG8_WAIT_L(0); PG8_BAR; PG8_MMA(0, 0, At, B0); PG8_MMA(0, 1, At, B1); PG8_BAR; PG8_SCHED;
            PG8_LDA(At, 1, 1); PG8_STAGE(PG8_SB(1, 0), b3, voffB); PG8_STAGE(PG8_SB(1, 1), b3 + hstep, voffB); PG8_STAGE(PG8_SA(1, 0), a3, voffA);
            PG8_WAIT_V(8); PG8_WAIT_L(0); PG8_BAR; PG8_MMA(1, 0, At, B0); PG8_MMA(1, 1, At, B1); PG8_BAR; PG8_SCHED;
            } else {
            PG8_LDB(B0, 0, 0); PG8_SCHED; PG8_LDA(At, 0, 0); PG8_STAGE(PG8_SA(1, 1), a1 + hstep, voffA);
            PG8_WAIT_L(8); PG8_BAR; PG8_WAIT_L(0); PG8_MMA(0, 0, At, B0); PG8_BAR; PG8_SCHED;
            PG8_LDB(B1, 0, 1); PG8_STAGE(PG8_SB(0, 0), b2, voffB);
            PG8_BAR; PG8_WAIT_L(0); PG8_MMA(0, 1, At, B1); PG8_BAR;
            PG8_LDA(At, 0, 1); PG8_STAGE(PG8_SA(0, 0), a2, voffA);
            PG8_BAR; PG8_WAIT_L(0); PG8_MMA(1, 0, At, B0); PG8_BAR; PG8_SCHED;
            PG8_STAGE(PG8_SB(0, 1), b2 + hstep, voffB);
            PG8_WAIT_V(6); PG8_BAR; PG8_MMA(1, 1, At, B1); PG8_BAR;
            PG8_LDB(B0, 1, 0); PG8_SCHED; PG8_LDA(At, 1, 0); PG8_STAGE(PG8_SA(0, 1), a2 + hstep, voffA);
            PG8_WAIT_L(8); PG8_BAR; PG8_WAIT_L(0); PG8_MMA(0, 0, At, B0); PG8_BAR; PG8_SCHED;
            PG8_LDB(B1, 1, 1); PG8_STAGE(PG8_SB(1, 0), b3, voffB);
            PG8_BAR; PG8_WAIT_L(0); PG8_MMA(0, 1, At, B1); PG8_BAR;
            PG8_LDA(At, 1, 1); PG8_STAGE(PG8_SA(1, 0), a3, voffA);
            PG8_BAR; PG8_WAIT_L(0); PG8_MMA(1, 0, At, B0); PG8_BAR; PG8_SCHED;
            PG8_STAGE(PG8_SB(1, 1), b3 + hstep, voffB);
            PG8_WAIT_V(6); PG8_BAR; PG8_MMA(1, 1, At, B1); PG8_BAR;
            }
        }
        if constexpr (ALIGN_EPI) { if (wr == 0) PG8_BAR; }
        if constexpr (!Epi::AFTER_DRAIN) { E(acc, cur, wr, wc, fr, fq); S.done(cur); }
        if (!has_next) break;
#pragma unroll
        for (int a = 0; a < 2; ++a)
#pragma unroll
            for (int b = 0; b < 2; ++b)
#pragma unroll
                for (int m = 0; m < 4; ++m)
#pragma unroll
                    for (int n = 0; n < 2; ++n) acc[a][b][m][n] = (f32x4){0.f, 0.f, 0.f, 0.f};
        cur = nxt; cA = nA; cB = nB; ++ui;
        if constexpr (ALIGN_EPI) { if (wr == 1) PG8_BAR; }
    }
    PG8_WAIT_V(0);
    if constexpr (!ALIGN_EPI) { if (wr == 0) PG8_BAR; }
    PG8_BAR;
    if constexpr (Epi::AFTER_DRAIN) { E.fused(acc, cur, wr, wc, fr, fq, lds, wid, lane); S.done(cur); }
#undef PG8_SA
#undef PG8_SB
#undef PG8_STAGE
#undef PG8_LDA
#undef PG8_LDB
#undef PG8_MMA
#undef PG8_WAIT_V
#undef PG8_WAIT_L
#undef PG8_BAR
#undef PG8_SCHED
}
}

#define LAS __attribute__((address_space(3)))
typedef unsigned short bf16;
typedef unsigned v4u __attribute__((ext_vector_type(4)));
typedef unsigned v2u __attribute__((ext_vector_type(2)));
typedef float f32x4 __attribute__((ext_vector_type(4)));
typedef float f32x16 __attribute__((ext_vector_type(16)));
typedef short bf16x8 __attribute__((ext_vector_type(8)));
typedef short v4i16_t __attribute__((ext_vector_type(4)));
__device__ __forceinline__ unsigned f2bf(float f) { unsigned u = __builtin_bit_cast(unsigned, f); return (u + 0x7fffu + ((u >> 16) & 1u)) >> 16; }
__device__ __forceinline__ unsigned pk2(float lo, float hi) { return f2bf(lo) | (f2bf(hi) << 16); }
__device__ __forceinline__ float bflo(unsigned w) { return __uint_as_float(w << 16); }
__device__ __forceinline__ float bfhi(unsigned w) { return __uint_as_float(w & 0xffff0000u); }
__device__ __forceinline__ float wave_sum(float v) {
#pragma unroll
    for (int o = 1; o < 64; o <<= 1) v += __shfl_xor(v, o);
    return v;
}
#define LDS_WAIT() asm volatile("s_waitcnt lgkmcnt(0)" ::: "memory")

#define XB_TMO      128
#define XB_XCNT(j)  (256  + 64 * (j))
#define XB_XSUB(j)  (1280 + 64 * (j))
#define XB_XGEN(j)  (2304 + 64 * (j))
#define XB_TOP      3328
#define XB_TOPGEN   3392
#define XCD_BAR_WORDS 3456
#define XB_SPIN_CAP (1u << 18)

__device__ __forceinline__ unsigned xb_ld(unsigned* p)              { return __hip_atomic_load(p, __ATOMIC_RELAXED, __HIP_MEMORY_SCOPE_AGENT); }
__device__ __forceinline__ unsigned xb_add(unsigned* p, unsigned v) { return __hip_atomic_fetch_add(p, v, __ATOMIC_RELAXED, __HIP_MEMORY_SCOPE_AGENT); }
__device__ __forceinline__ unsigned xb_xcc_id() { return (unsigned)__builtin_amdgcn_s_getreg((3 << 11) | 20) & 0xFu; }
#define XB_SPIN(cond, bar) do { unsigned _sp = 0; while (cond) { __builtin_amdgcn_s_sleep(1); \
    if ((++_sp & 255u) == 0u) { if (xb_ld(&(bar)[XB_TMO])) break; if (_sp > XB_SPIN_CAP) { atomicAdd(&(bar)[XB_TMO], 1u); break; } } } } while (0)

struct XcdBarrier {
    unsigned* bar; unsigned x;
    volatile LAS unsigned* st;
};

__device__ __forceinline__ XcdBarrier xcd_barrier_post(unsigned* bar, volatile LAS unsigned* st) {
    XcdBarrier b; b.bar = bar; b.x = xb_xcc_id(); b.st = st;
    if (threadIdx.x == 0) (void)xb_add(&bar[XB_XCNT(b.x)], 1u);
    return b;
}
__device__ __forceinline__ void xcd_barrier_complete(unsigned* bar, unsigned x, unsigned& nloc, unsigned& nx) {
    const unsigned G = gridDim.x * gridDim.y * gridDim.z;
    unsigned sum, cnt, mine, sp = 0u;
    for (;;) {
        sum = 0u; cnt = 0u; mine = 0u;
#pragma unroll
        for (unsigned j = 0; j < 16; ++j) { const unsigned c = xb_ld(&bar[XB_XCNT(j)]); sum += c; cnt += (c > 0u) ? 1u : 0u; mine = (j == x) ? c : mine; }
        if (sum == G) break;
        __builtin_amdgcn_s_sleep(1);
        if ((++sp & 255u) == 0u) { if (xb_ld(&bar[XB_TMO])) break; if (sp > XB_SPIN_CAP) { atomicAdd(&bar[XB_TMO], 1u); break; } }
    }
    nloc = mine > 0u ? mine : 1u; nx = cnt > 0u ? cnt : 1u;
}

__device__ __forceinline__ void xcd_barrier(const XcdBarrier& b) {
    asm volatile("s_waitcnt vmcnt(0)" ::: "memory");
    __syncthreads();
    if (threadIdx.x == 0) {
        unsigned* bar = b.bar;
        __builtin_amdgcn_s_waitcnt(0);
        unsigned nloc = b.st[0], nx = b.st[1];
        if (nloc == 0u) { xcd_barrier_complete(bar, b.x, nloc, nx); b.st[0] = nloc; b.st[1] = nx; }
        const unsigned old = xb_add(&bar[XB_XSUB(b.x)], 1u);
        const unsigned gen = old / nloc;
        if (old + 1u == (gen + 1u) * nloc) {
            __builtin_amdgcn_fence(__ATOMIC_RELEASE, "agent");
            asm volatile("s_waitcnt vmcnt(0)" ::: "memory");
            const unsigned og = xb_add(&bar[XB_TOP], 1u);
            const unsigned tg = og / nx;
            if (og + 1u == (tg + 1u) * nx) xb_add(&bar[XB_TOPGEN], 1u);
            else XB_SPIN(xb_ld(&bar[XB_TOPGEN]) == tg, bar);
            __builtin_amdgcn_fence(__ATOMIC_ACQUIRE, "agent");
            xb_add(&bar[XB_XGEN(b.x)], 1u);
            asm volatile("s_waitcnt vmcnt(0)" ::: "memory");
        } else {
            XB_SPIN(xb_ld(&bar[XB_XGEN(b.x)]) == gen, bar);
            __builtin_amdgcn_fence(__ATOMIC_ACQUIRE, "agent");
            asm volatile("s_waitcnt vmcnt(0)" ::: "memory");
        }
    }
    __syncthreads();
}

constexpr size_t MiB = 1u << 20;
constexpr size_t WS_ACC = 7 * MiB;
constexpr size_t WS_RS0 = 1 * MiB, WS_SSQ1 = 2 * MiB, WS_SSQ2 = 3 * MiB, WS_SSQ3 = 4 * MiB, WS_SSQ4 = 5 * MiB, WS_LUT = 6 * MiB;
constexpr size_t WS_WIN = 8 * MiB, WS_WOUT = 13 * MiB, WS_WUP0 = 16 * MiB, WS_WDN0 = 24 * MiB, WS_WKVQ = 32 * MiB, WS_WO = 38 * MiB,
                 WS_WUP1 = 40 * MiB, WS_WDN1 = 48 * MiB, WS_WG = 56 * MiB, WS_CKB = 58 * MiB, WS_CVB = 75 * MiB;
constexpr size_t WS_ACT = 96 * MiB;
constexpr size_t WS_GATE = 96 * MiB, WS_XR = 258 * MiB, WS_Z = 420 * MiB;
constexpr size_t WS_KB = 96 * MiB, WS_VB = 225 * MiB, WS_QB = 354 * MiB, WS_OB = 483 * MiB;
constexpr size_t WS_H0 = 612 * MiB, WS_H1 = 741 * MiB, WS_H2 = 870 * MiB, WS_H3 = 612 * MiB, WS_END = 999 * MiB;

namespace att {
constexpr int RSK = 272, TILEB = 16384, KST = 0, VST = 3 * TILEB, LUT_OFF = 6 * TILEB;
__device__ __forceinline__ void glds16(const void* gsrc, unsigned lds_dst) { unsigned keep;
  asm volatile("s_mov_b32 %0, m0\n\ts_mov_b32 m0, %2\n\ts_nop 0\n\tglobal_load_lds_dwordx4 %1, off\n\ts_mov_b32 m0, %0" : "=&s"(keep) : "v"(gsrc), "s"(lds_dst) : "memory"); }
constexpr float NEG = -1e30f;
__device__ __forceinline__ int crow(int r, int hi) { return (r & 3) + 8 * (r >> 2) + 4 * hi; }
typedef float f32x2_t __attribute__((ext_vector_type(2))); typedef __bf16 bf16x2_t __attribute__((ext_vector_type(2)));
__device__ __forceinline__ float max3f(float a, float b, float c) { float r; asm("v_max3_f32 %0, %1, %2, %3" : "=v"(r) : "v"(a), "v"(b), "v"(c)); return r; }
__device__ __forceinline__ unsigned cvtpk(float lo, float hi) { f32x2_t v = {lo, hi}; bf16x2_t b = __builtin_convertvector(v, bf16x2_t); return __builtin_bit_cast(unsigned, b); }

__device__ __forceinline__ void attn_unit(LAS unsigned char* lds, const bf16* Qh, bf16* Oh, int nqw, int qpos0,
                                          const bf16* kmeta, const bf16* vmeta, const bf16* kmain, const bf16* vmain, int nmain,
                                          const float* lut_g, float c15, float lam, int abl, const bool ksplit) {
    const int tid = otid(), lane = tid & 63, r32 = lane & 31, hi = lane >> 5;
    const int wid = __builtin_amdgcn_readfirstlane(tid >> 6), pair = wid >> 1, map = wid & 1;
    const bool active = ksplit || pair < nqw;
    const int qposw = qpos0 + (ksplit ? 0 : 32 * pair);
    const int tmask = ksplit ? 3 : 0, tsel = ksplit ? pair : 0;
    int klim = 64 * (qposw / 64 + 1); klim = klim < nmain ? klim : nmain;
    const int ntw = active ? 1 + (klim + 63) / 64 : 0;
    int klimb = 64 * ((qpos0 + 32 * (nqw - 1)) / 64 + 1); klimb = klimb < nmain ? klimb : nmain;
    const int nt = 1 + (klimb + 63) / 64;
    LAS float* lut = (LAS float*)(lds + LUT_OFF);
    constexpr int QST = LUT_OFF + 1024;
    const int qoff = QST + ((active && !ksplit ? 32 * pair : 0) + r32) * RSK + (64 * map + 8 * hi) * 2;
    f32x16 o[4];
#pragma unroll
    for (int d = 0; d < 4; ++d)
#pragma unroll
        for (int r = 0; r < 16; ++r) o[d][r] = 0.f;
    float lrow = 0.f;
    const unsigned ldsb = (unsigned)(uintptr_t)lds;
    const int dr0 = 8 * wid + (lane >> 4), dr1 = dr0 + 4, dsl = lane & 15;
    const int kc0 = (dsl ^ (dr0 & 15)) * 8, kc1 = (dsl ^ (dr1 & 15)) * 8, vc0 = (dsl ^ ((dr0 & 3) << 2)) * 8;
#define ATT_SRC(t, pm_, pn_) const int t_ = (t); const bf16* src_; int nv_; \
        if (t_ == 0) { src_ = pm_; nv_ = 16; } else { const int k0_ = 64 * (t_ - 1); src_ = pn_ + (size_t)k0_ * DM; nv_ = nmain - k0_; nv_ = nv_ > 64 ? 64 : nv_; } \
        const int ra_ = dr0 < nv_ ? dr0 : nv_ - 1, rb_ = dr1 < nv_ ? dr1 : nv_ - 1;
#define ATT_DMAK(t, s) do { ATT_SRC(t, kmeta, kmain) const unsigned d_ = (unsigned)__builtin_amdgcn_readfirstlane(ldsb + KST + (s) * TILEB + wid * 2048); \
        glds16(src_ + (size_t)ra_ * DM + kc0, d_); glds16(src_ + (size_t)rb_ * DM + kc1, d_ + 1024); } while (0)
#define ATT_DMAV(t, s) do { ATT_SRC(t, vmeta, vmain) const unsigned d_ = (unsigned)__builtin_amdgcn_readfirstlane(ldsb + VST + (s) * TILEB + wid * 2048); \
        glds16(src_ + (size_t)ra_ * DM + vc0, d_); glds16(src_ + (size_t)rb_ * DM + vc0, d_ + 1024); } while (0)
#define ATT_WAITBAR(n) asm volatile("s_waitcnt vmcnt(" #n ") lgkmcnt(0)\n\ts_barrier" ::: "memory")
    const int kx = KST + r32 * 256 + (((8 * map + hi) ^ (r32 & 15)) << 4);
    const int vq_ = (lane >> 2) & 3;
    const int vx = VST + (4 * hi + vq_) * 256 + (2 * ((lane >> 4) & 1) + ((lane & 3) >> 1)) * 16 + (lane & 1) * 8;
    int vxd[4];
#pragma unroll
    for (int d = 0; d < 4; ++d) vxd[d] = vx + ((d ^ vq_) << 6);
    const int qpos = qposw + r32;
    const bool qk_first = wid < 4;
#define ATT_QK(t, sk, S0, S1) do { const int tq_ = (t); const int kp_ = tq_ == 0 ? -16 : 64 * (tq_ - 1); \
        LAS unsigned char* kb_ = lds + (sk) * TILEB; \
        _Pragma("unroll") for (int r = 0; r < 16; ++r) { S0[r] = 0.f; S1[r] = 0.f; } \
        _Pragma("unroll") for (int ds = 0; ds < 4; ++ds) { \
            const bf16x8 ka_ = *(const LAS bf16x8*)(kb_ + (kx ^ (ds << 5))); const bf16x8 kc_ = *(const LAS bf16x8*)(kb_ + (kx ^ (ds << 5)) + 8192); \
            S0 = __builtin_amdgcn_mfma_f32_32x32x16_bf16(ka_, qf[ds], S0, 0, 0, 0); S1 = __builtin_amdgcn_mfma_f32_32x32x16_bf16(kc_, qf[ds], S1, 0, 0, 0); } \
        } while (0)
#define ATT_SMPV(t, sv, S0, S1, SX0, SX1) do { const int ts_ = (t); \
        LAS unsigned char* vb_ = lds + (sv) * TILEB; \
        const int kpos0 = ts_ == 0 ? -16 : 64 * (ts_ - 1); \
        int nvalid = ts_ == 0 ? 16 : (nmain - kpos0); nvalid = nvalid > 64 ? 64 : nvalid; \
        if ((qposw - (kpos0 + 63)) < 128) { \
            const int rb = kpos0 - qpos + 128; \
            _Pragma("unroll") for (int r = 0; r < 16; ++r) { int i0 = rb + crow(r, hi); i0 = i0 < 0 ? 0 : i0; S0[r] += lut[i0]; } \
            _Pragma("unroll") for (int r = 0; r < 16; ++r) { int i1 = rb + 32 + crow(r, hi); i1 = i1 < 0 ? 0 : (i1 > 191 ? 191 : i1); S1[r] += lut[i1]; } \
        } \
        if (nvalid < 64) { \
            _Pragma("unroll") for (int r = 0; r < 16; ++r) { const int kv = crow(r, hi); if (kv >= nvalid) S0[r] = NEG; if (kv + 32 >= nvalid) S1[r] = NEG; } \
        } \
        float ls = 0.f; \
        _Pragma("unroll") for (int ks = 0; ks < 4; ++ks) { \
            float e_[8]; \
            _Pragma("unroll") for (int j = 0; j < 8; ++j) { e_[j] = __builtin_amdgcn_exp2f(ks < 2 ? S0[8 * (ks & 1) + j] : S1[8 * (ks & 1) + j]); ls += e_[j]; } \
            v4u pw_; pw_.x = cvtpk(e_[0], e_[1]); pw_.y = cvtpk(e_[2], e_[3]); pw_.z = cvtpk(e_[4], e_[5]); pw_.w = cvtpk(e_[6], e_[7]); \
                _Pragma("unroll") for (int d = 0; d < 4; ++d) { \
                const v4i16_t lo = __builtin_amdgcn_ds_read_tr16_b64_v4i16((LAS v4i16_t*)(vb_ + vxd[d] + ks * 4096)); \
                const v4i16_t hh = __builtin_amdgcn_ds_read_tr16_b64_v4i16((LAS v4i16_t*)(vb_ + vxd[d] + ks * 4096 + 2048)); \
                const bf16x8 vf = (bf16x8){lo[0], lo[1], lo[2], lo[3], hh[0], hh[1], hh[2], hh[3]}; \
                o[d] = __builtin_amdgcn_mfma_f32_32x32x16_bf16(vf, __builtin_bit_cast(bf16x8, pw_), o[d], 0, 0, 0); } \
        } \
        lrow += ls; } while (0)
#define ATT_STEP(t) do { const int tt_ = (t); \
        if (tt_ < ntw && (tt_ & tmask) == tsel && !(abl & 2)) ATT_QK(tt_, s0, sa0, sa1); \
        if (tt_ + 2 < nt) { ATT_DMAK(tt_ + 2, s2); ATT_DMAV(tt_ + 2, s2); }     \
        if (tt_ < ntw && (tt_ & tmask) == tsel && !(abl & 1)) ATT_SMPV(tt_, s0, sa0, sa1, sa0, sa1); \
        if (tt_ + 2 < nt) ATT_WAITBAR(4); else ATT_WAITBAR(0); \
        { const int r_ = s0; s0 = s1; s1 = s2; s2 = r_; } } while (0)
    asm volatile("s_waitcnt vmcnt(0)" ::: "memory");
    ATT_DMAK(0, 0); ATT_DMAV(0, 0); ATT_DMAK(1, 1); ATT_DMAV(1, 1);
    if (tid < 192) lut[tid] = lut_g[tid] - c15;
    for (int c = tid; c < nqw * 32 * 16; c += 512) *(LAS v4u*)(lds + QST + (c >> 4) * RSK + (c & 15) * 16) = *(const v4u*)(Qh + (size_t)(c >> 4) * DM + (c & 15) * 8);
    ATT_WAITBAR(0);
    bf16x8 qf[4];
#pragma unroll
    for (int ds = 0; ds < 4; ++ds) qf[ds] = *(const LAS bf16x8*)(lds + qoff + ds * 32);
    int s0 = 0, s1 = 1, s2 = 2;
    f32x16 sa0, sa1;
#pragma unroll
    for (int r = 0; r < 16; ++r) { sa0[r] = 0.f; sa1[r] = 0.f; }
    for (int t = 0; t < nt; ++t) ATT_STEP(t);
#undef ATT_SRC
#undef ATT_DMAK
#undef ATT_DMAV
#undef ATT_WAITBAR
#undef ATT_QK
#undef ATT_SMPV
#undef ATT_STEP
    if (ksplit) {
        LAS float* Xs = (LAS float*)lds + ((pair - 1) * 2 + map) * (65 * 64) + lane;
        if (pair > 0) {
#pragma unroll
            for (int d = 0; d < 4; ++d)
#pragma unroll
                for (int r = 0; r < 16; ++r) Xs[(d * 16 + r) * 64] = o[d][r];
            Xs[64 * 64] = lrow;
        }
        __syncthreads();
        if (pair == 0) {
#pragma unroll 1
            for (int p = 0; p < 3; ++p) {
                const LAS float* Xr = (const LAS float*)lds + (p * 2 + map) * (65 * 64) + lane;
#pragma unroll
                for (int d = 0; d < 4; ++d)
#pragma unroll
                    for (int r = 0; r < 16; ++r) o[d][r] += Xr[(d * 16 + r) * 64];
                lrow += Xr[64 * 64];
            }
        }
        __syncthreads();
    }
    const bool fin = ksplit ? pair == 0 : active;
    lrow += __shfl_xor(lrow, 32);
    const float inv = 1.0f / lrow;
    LAS float* X = (LAS float*)lds + pair * 4096 + lane;
    if (fin && map == 1) {
#pragma unroll
        for (int d = 0; d < 4; ++d)
#pragma unroll
            for (int r = 0; r < 16; ++r) X[(d * 16 + r) * 64] = o[d][r] * inv;
    }
    __syncthreads();
    if (fin && map == 0) {
        float q = 0.f;
#pragma unroll
        for (int d = 0; d < 4; ++d)
#pragma unroll
            for (int r = 0; r < 16; ++r) { const float v = o[d][r] * inv - lam * X[(d * 16 + r) * 64]; o[d][r] = v; q += v * v; }
        q += __shfl_xor(q, 32);
        const float rs = __builtin_amdgcn_rsqf(q * (1.0f / 128.0f) + EPS);
        bf16* op = Oh + (size_t)((ksplit ? 0 : 32 * pair) + r32) * DM + 4 * hi;
#pragma unroll
        for (int d = 0; d < 4; ++d)
#pragma unroll
            for (int g = 0; g < 4; ++g) {
                v2u w; w.x = pg8::cvt_pk_bf16(o[d][4 * g] * rs, o[d][4 * g + 1] * rs); w.y = pg8::cvt_pk_bf16(o[d][4 * g + 2] * rs, o[d][4 * g + 3] * rs);
                *(v2u*)(op + 32 * d + 8 * g) = w;
            }
    }
    __syncthreads();
}
}

struct Args {
    const float* in[33];
    float* out; unsigned char* ws;
};

__device__ __forceinline__ void p0_transpose_item(const float* W, int K, int N, bf16* WT, int row_off, const float* gain, int gmask, float scal, LAS float* scr, int item, int lane) {
    const int nblk = N / 32, kb = item / nblk, nb = item % nblk, k0 = 64 * kb, n0 = 32 * nb;
#pragma unroll 8
    for (int i = 0; i < 32; ++i) { const int kk = 2 * i + (lane >> 5); const float g = gain ? gain[(k0 + kk) & gmask] * scal : scal;
        scr[kk * 33 + (lane & 31)] = W[(size_t)(k0 + kk) * N + n0 + (lane & 31)] * g; }
    LDS_WAIT(); asm volatile("" ::: "memory");
    const int c = lane & 7;
#pragma unroll
    for (int j = 0; j < 4; ++j) { const int n = (lane >> 3) + 8 * j; const LAS float* s = scr + (8 * c) * 33 + n;
        v4u o; o.x = pk2(s[0 * 33], s[1 * 33]); o.y = pk2(s[2 * 33], s[3 * 33]); o.z = pk2(s[4 * 33], s[5 * 33]); o.w = pk2(s[6 * 33], s[7 * 33]);
        *(v4u*)(WT + (size_t)(row_off + n0 + n) * K + k0 + 8 * c) = o; }
    LDS_WAIT(); asm volatile("" ::: "memory");
}
__device__ __forceinline__ float row_to_bf16(const float* xrow, bf16* orow, int lane) {
    const f32x4* xr = (const f32x4*)xrow + lane;
    f32x4 v[4]; float s = 0.f;
#pragma unroll
    for (int j = 0; j < 4; ++j) { v[j] = xr[64 * j]; s += (v[j].x * v[j].x + v[j].y * v[j].y) + (v[j].z * v[j].z + v[j].w * v[j].w); }
    v2u* o8 = (v2u*)orow + lane;
#pragma unroll
    for (int j = 0; j < 4; ++j) { v2u w; w.x = pk2(v[j].x, v[j].y); w.y = pk2(v[j].z, v[j].w); o8[64 * j] = w; }
    return wave_sum(s);
}
__device__ __forceinline__ int t5_bucket(int rel) {
    const int ret = rel > 0 ? 16 : 0; const int n = rel < 0 ? -rel : rel;
    int b;
    if (n < 8) b = n; else if (n < 12) b = 8; else if (n < 16) b = 9; else if (n < 23) b = 10; else if (n < 32) b = 11;
    else if (n < 46) b = 12; else if (n < 64) b = 13; else if (n < 91) b = 14; else b = 15;
    return ret + b;
}

enum { I_XP = 0, I_XS, I_SH, I_SC, I_CMK, I_CMV, I_CK, I_CV, I_META, I_GMIX, I_GMLP, I_WUP, I_WDN, I_WIN, I_CONVW, I_CONVB,
       I_WGR, I_BGR, I_WGI, I_BGI, I_LAM, I_WOUT, I_GKV, I_WKV, I_WQ, I_LQ1, I_LK1, I_LQ2, I_LK2, I_GSUB, I_WO, I_RELB, I_GF };

__device__ __forceinline__ void p0_prologue(const Args& A, LAS unsigned char* lds) {
    unsigned char* ws = A.ws;
    const int tid_ = otid(), lane = tid_ & 63, wave = __builtin_amdgcn_readfirstlane(tid_ >> 6);
    LAS float* scr = (LAS float*)(lds + wave * 16384);
    const int gw = blockIdx.x * 8 + wave, NGW = gridDim.x * 8;
    constexpr int N_IN = 16 * 80, N_OUT = 20 * 32, N_UP = 16 * 128, N_DN = 64 * 32, N_KV = 16 * 64, N_Q = 16 * 32, N_O = 16 * 32, N_G = 80;
    constexpr int NITEMS = N_IN + N_OUT + 2 * N_UP + 2 * N_DN + N_KV + N_Q + N_O + N_G;
    for (int it = gw; it < NITEMS; it += NGW) {
        int r = it;
        if (r < N_IN) { p0_transpose_item(A.in[I_WIN], 1024, 2560, (bf16*)(ws + WS_WIN), 0, A.in[I_GMIX], 0xffff, 1.f, scr, r, lane); continue; } r -= N_IN;
        if (r < N_OUT) { p0_transpose_item(A.in[I_WOUT], 1280, 1024, (bf16*)(ws + WS_WOUT), 0, nullptr, 0, 1.f, scr, r, lane); continue; } r -= N_OUT;
        if (r < N_UP) { p0_transpose_item(A.in[I_WUP], 1024, 4096, (bf16*)(ws + WS_WUP0), 0, A.in[I_GMLP], 0xffff, 1.f, scr, r, lane); continue; } r -= N_UP;
        if (r < N_UP) { p0_transpose_item(A.in[I_WUP] + (size_t)1024 * 4096, 1024, 4096, (bf16*)(ws + WS_WUP1), 0, A.in[I_GMLP] + 1024, 0xffff, 1.f, scr, r, lane); continue; } r -= N_UP;
        if (r < N_DN) { p0_transpose_item(A.in[I_WDN], 4096, 1024, (bf16*)(ws + WS_WDN0), 0, nullptr, 0, 1.f, scr, r, lane); continue; } r -= N_DN;
        if (r < N_DN) { p0_transpose_item(A.in[I_WDN] + (size_t)4096 * 1024, 4096, 1024, (bf16*)(ws + WS_WDN1), 0, nullptr, 0, 1.f, scr, r, lane); continue; } r -= N_DN;
        if (r < N_KV) { p0_transpose_item(A.in[I_WKV], 1024, 2048, (bf16*)(ws + WS_WKVQ), 0, A.in[I_GKV], 0xffff, 1.f, scr, r, lane); continue; } r -= N_KV;
        if (r < N_Q) { p0_transpose_item(A.in[I_WQ], 1024, 1024, (bf16*)(ws + WS_WKVQ), 2048, A.in[I_GMIX] + 1024, 0xffff, QSCALE, scr, r, lane); continue; } r -= N_Q;
        if (r < N_O) { p0_transpose_item(A.in[I_WO], 1024, 1024, (bf16*)(ws + WS_WO), 0, A.in[I_GSUB], 127, 1.0f - LAM_INIT, scr, r, lane); continue; } r -= N_O;
        { const int n = r >> 3, sub = r & 7;
          p0_transpose_item(A.in[I_WGR] + (size_t)n * 16384, 128, 128, (bf16*)(ws + WS_WG) + (size_t)n * 256 * 128, 0, nullptr, 0, 1.f, scr, sub, lane);
          p0_transpose_item(A.in[I_WGI] + (size_t)n * 16384, 128, 128, (bf16*)(ws + WS_WG) + (size_t)n * 256 * 128, 128, nullptr, 0, 1.f, scr, sub, lane); }
    }
    bf16* H0 = (bf16*)(ws + WS_H0); float* rs0 = (float*)(ws + WS_RS0);
    for (int row = gw; row < R_SAMP; row += 4 * NGW) {
        f32x4 v[4][4];
#pragma unroll
        for (int k = 0; k < 4; ++k) { const int rr = row + k * NGW < R_SAMP ? row + k * NGW : row; const f32x4* xr = (const f32x4*)(A.in[I_XP] + (size_t)rr * DM) + lane;
#pragma unroll
            for (int j = 0; j < 4; ++j) v[k][j] = xr[64 * j]; }
#pragma unroll
        for (int k = 0; k < 4; ++k) {
            const int rr = row + k * NGW;
            float sq = 0.f;
#pragma unroll
            for (int j = 0; j < 4; ++j) sq += (v[k][j].x * v[k][j].x + v[k][j].y * v[k][j].y) + (v[k][j].z * v[k][j].z + v[k][j].w * v[k][j].w);
            sq = wave_sum(sq);
            if (rr < R_SAMP) {
                v2u* o8 = (v2u*)(H0 + (size_t)rr * DM) + lane;
#pragma unroll
                for (int j = 0; j < 4; ++j) { v2u w; w.x = pk2(v[k][j].x, v[k][j].y); w.y = pk2(v[k][j].z, v[k][j].w); o8[64 * j] = w; }
                if (lane == 0) rs0[rr] = 1.0f / sqrtf(sq * (1.0f / DM) + EPS);
            }
        }
    }
    for (int row = R_SAMP + gw; row < MROWS; row += NGW) {
        if (row < R_PAD) {
            const float* src = row < R_META ? A.in[I_XS] + (size_t)(row - R_SAMP) * DM : A.in[I_META] + (size_t)(row - R_META) * DM;
            const float s = row_to_bf16(src, H0 + (size_t)row * DM, lane);
            if (lane == 0) rs0[row] = 1.0f / sqrtf(s * (1.0f / DM) + EPS);
        } else {
            v4u z = {0u, 0u, 0u, 0u}; v4u* o = (v4u*)(H0 + (size_t)row * DM) + lane; o[0] = z; o[64] = z;
            if (lane == 0) rs0[row] = 0.f;
        }
    }
    for (int j = gw; j < 8 * 1040; j += NGW) {
        const int b = j / 1040, r = j % 1040;
        const float* sk = r < 16 ? A.in[I_CMK] + (size_t)(b * 16 + r) * DM : A.in[I_CK] + (size_t)(b * 1024 + r - 16) * DM;
        const float* sv = r < 16 ? A.in[I_CMV] + (size_t)(b * 16 + r) * DM : A.in[I_CV] + (size_t)(b * 1024 + r - 16) * DM;
        (void)row_to_bf16(sk, (bf16*)(ws + WS_CKB) + (size_t)(b * 1072 + r) * DM, lane);
        (void)row_to_bf16(sv, (bf16*)(ws + WS_CVB) + (size_t)(b * 1072 + r) * DM, lane);
    }
    for (int i = gw; i < 27; i += NGW) {
        bf16* dst = (bf16*)(ws + WS_XR) + (size_t)(R_HALO_S + i) * DR;
        for (int c = lane; c < DR; c += 64) dst[c] = i < 24 ? (bf16)f2bf(A.in[I_SC][(size_t)i * DR + c]) : (bf16)0;
    }
    { float* z = (float*)(ws + WS_SSQ1); const int n = 4 * (int)(MiB / 4); for (int i = gw * 64 + lane; i < n; i += NGW * 64) z[i] = 0.f; }
    { float* z = (float*)(ws + WS_ACC); for (int i = gw * 64 + lane; i < 256 * DM; i += NGW * 64) z[i] = 0.f; }
    { float* lut = (float*)(ws + WS_LUT); for (int i = gw * 64 + lane; i < 8 * 192; i += NGW * 64) { const int h = i / 192, k = i % 192; lut[i] = A.in[I_RELB][t5_bucket(k - 128) * 8 + h] * LOG2E; } }
}

namespace rnn {
constexpr int RSX = 272;
constexpr int XC_OFF = 0, HS_OFF = 128 * RSX;
__device__ __forceinline__ void chain(const Args& A, LAS unsigned char* lds, int ch) {
    unsigned char* ws = A.ws;
    const int tid = otid(), lane = tid & 63, fr = lane & 15, fq = lane >> 4;
    const int w = __builtin_amdgcn_readfirstlane(tid >> 6);
    const bool samp = ch >= 160;
    const int b = samp ? (ch - 160) / 10 : ch / 10, n = samp ? (ch - 160) % 10 : ch % 10;
    const bf16* XR = (const bf16*)(ws + WS_XR); const bf16* GATE = (const bf16*)(ws + WS_GATE); bf16* Z = (bf16*)(ws + WS_Z);
    const bf16* wg = (const bf16*)(ws + WS_WG) + (size_t)n * 256 * 128;
    bf16x8 Br[4], Bi[4];
#pragma unroll
    for (int ks = 0; ks < 4; ++ks) { Br[ks] = *(const bf16x8*)(wg + (size_t)(16 * w + fr) * 128 + 32 * ks + 8 * fq); Bi[ks] = *(const bf16x8*)(wg + (size_t)(128 + 16 * w + fr) * 128 + 32 * ks + 8 * fq); }
    const int c = 128 * n + 16 * w + fr;
    const float nbr = -A.in[I_BGR][c] * LOG2E, nbi = -A.in[I_BGI][c] * LOG2E;
    const float sp = 8.0f * log1pf(expf(-A.in[I_LAM][c])) * LOG2E;
    float carry = samp ? A.in[I_SH][(size_t)b * DR + c] : 0.f;
    const int cgp = tid & 15, tg = tid >> 4;
    const int ccol = 128 * n + 8 * cgp;
    constexpr int CW_OFF = 2 * 128 * RSX;
    __syncthreads();
    for (int i = tid; i < 640; i += 512) { const int j = i >> 7, cc = i & 127; ((LAS float*)(lds + CW_OFF))[i] = j < 4 ? A.in[I_CONVW][(size_t)j * DR + 128 * n + cc] : A.in[I_CONVB][128 * n + cc]; }
    const int nseg = samp ? 1 : 33;
#define RNN_SEG(sg_) int row0, ntok, hrow; bool wz = true; \
        if (samp) { row0 = R_SAMP + 32 * b; ntok = 32; hrow = R_HALO_S + 3 * b; } \
        else if ((sg_) == 0) { row0 = R_META; ntok = 16; hrow = R_HALO_Z; wz = (b == 0); } \
        else { row0 = b * 4096 + 128 * ((sg_) - 1); ntok = 128; hrow = (sg_) == 1 ? R_META + 13 : row0 - 3; }
#define RNN_LOADX(sg_) do { RNN_SEG(sg_) (void)wz; if (4 * tg < ntok) { \
        _Pragma("unroll") for (int d = 0; d < 7; ++d) { const int tok = 4 * tg - 3 + d; const int grow = tok < 0 ? hrow + 3 + tok : row0 + tok; x[d] = *(const v4u*)(XR + (size_t)grow * DR + ccol); } } } while (0)
    v4u x[7];
#pragma unroll
    for (int d = 0; d < 7; ++d) x[d] = (v4u){0u, 0u, 0u, 0u};
    RNN_LOADX(0);
    __syncthreads();
    for (int sg = 0; sg < nseg; ++sg) {
        RNN_SEG(sg)
        const int nm = ntok >> 4;
        v4u gv[4];
#pragma unroll
        for (int j = 0; j < 4; ++j) gv[j] = (v4u){0u, 0u, 0u, 0u};
        if (wz && 4 * tg < ntok) {
#pragma unroll
            for (int j = 0; j < 4; ++j) gv[j] = *(const v4u*)(GATE + (size_t)(row0 + 4 * tg + j) * DR + ccol);
        }
        if (4 * tg < ntok) {
            f32x4 cw[4][2], cb[2];
#pragma unroll
            for (int j = 0; j < 4; ++j) { cw[j][0] = *(const LAS f32x4*)(lds + CW_OFF + (j * 128 + 8 * cgp) * 4); cw[j][1] = *(const LAS f32x4*)(lds + CW_OFF + (j * 128 + 8 * cgp + 4) * 4); }
            cb[0] = *(const LAS f32x4*)(lds + CW_OFF + (4 * 128 + 8 * cgp) * 4); cb[1] = *(const LAS f32x4*)(lds + CW_OFF + (4 * 128 + 8 * cgp + 4) * 4);
#pragma unroll
            for (int j = 0; j < 4; ++j) {
                f32x4 a0 = cb[0], a1 = cb[1];
#pragma unroll
                for (int d = 0; d < 4; ++d) { const v4u xv = x[j + d];
                    a0[0] += cw[d][0][0] * bflo(xv.x); a0[1] += cw[d][0][1] * bfhi(xv.x); a0[2] += cw[d][0][2] * bflo(xv.y); a0[3] += cw[d][0][3] * bfhi(xv.y);
                    a1[0] += cw[d][1][0] * bflo(xv.z); a1[1] += cw[d][1][1] * bfhi(xv.z); a1[2] += cw[d][1][2] * bflo(xv.w); a1[3] += cw[d][1][3] * bfhi(xv.w); }
                v4u o; o.x = pg8::cvt_pk_bf16(a0[0], a0[1]); o.y = pg8::cvt_pk_bf16(a0[2], a0[3]); o.z = pg8::cvt_pk_bf16(a1[0], a1[1]); o.w = pg8::cvt_pk_bf16(a1[2], a1[3]);
                *(LAS v4u*)(lds + XC_OFF + (4 * tg + j) * RSX + cgp * 16) = o;
            }
        }
        if (sg + 1 < nseg) RNN_LOADX(sg + 1);
        __syncthreads();
        f32x4 aR[8], aI[8];
#pragma unroll
        for (int m = 0; m < 8; ++m) {
            aR[m] = (f32x4){0.f, 0.f, 0.f, 0.f}; aI[m] = (f32x4){0.f, 0.f, 0.f, 0.f};
            if (m < nm) {
#pragma unroll
                for (int ks = 0; ks < 4; ++ks) {
                    const bf16x8 af = *(const LAS bf16x8*)(lds + XC_OFF + (16 * m + fr) * RSX + (32 * ks + 8 * fq) * 2);
                    aR[m] = __builtin_amdgcn_mfma_f32_16x16x32_bf16(af, Br[ks], aR[m], 0, 0, 0);
                    aI[m] = __builtin_amdgcn_mfma_f32_16x16x32_bf16(af, Bi[ks], aI[m], 0, 0, 0);
                }
            }
        }
#pragma unroll
        for (int m = 0; m < 8; ++m) {
            if (m < nm) {
                float P[4], S[4]; float Ap = 1.f, Sp = 0.f;
#pragma unroll
                for (int j = 0; j < 4; ++j) {
                    const int t = 16 * m + 4 * fq + j;
                    const float xcv = __uint_as_float((unsigned)(*(const LAS unsigned short*)(lds + XC_OFF + t * RSX + (16 * w + fr) * 2)) << 16);
                    const float r = __builtin_amdgcn_rcpf(1.f + __builtin_amdgcn_exp2f(__builtin_fmaf(aR[m][j], -LOG2E, nbr)));
                    const float ig = __builtin_amdgcn_rcpf(1.f + __builtin_amdgcn_exp2f(__builtin_fmaf(aI[m][j], -LOG2E, nbi)));
                    const float a = __builtin_amdgcn_exp2f(-sp * r);
                    const float uu = __builtin_amdgcn_sqrtf(__builtin_fmaf(-a, a, 1.0f)) * ig * xcv;
                    Sp = a * Sp + uu; Ap = Ap * a; P[j] = Ap; S[j] = Sp;
                }
                { const float A1 = __shfl_up(Ap, 16), U1 = __shfl_up(Sp, 16); if (fq >= 1) { Sp = Ap * U1 + Sp; Ap = Ap * A1; } }
                { const float A2 = __shfl_up(Ap, 32), U2 = __shfl_up(Sp, 32); if (fq >= 2) { Sp = Ap * U2 + Sp; Ap = Ap * A2; } }
                float Ae = __shfl_up(Ap, 16), Ue = __shfl_up(Sp, 16); if (fq == 0) { Ae = 1.f; Ue = 0.f; }
                const float hin = Ae * carry + Ue;
#pragma unroll
                for (int j = 0; j < 4; ++j) {
                    const int t = 16 * m + 4 * fq + j;
                    *(LAS unsigned short*)(lds + HS_OFF + t * RSX + (16 * w + fr) * 2) = (unsigned short)att::cvtpk(P[j] * hin + S[j], 0.f);
                }
                const float At = __shfl(Ap, 48 + fr), Ut = __shfl(Sp, 48 + fr);
                carry = At * carry + Ut;
            }
        }
        __syncthreads();
        if (wz && 4 * tg < ntok) {
#pragma unroll
            for (int j = 0; j < 4; ++j) {
                const int tok = 4 * tg + j; const size_t go = (size_t)(row0 + tok) * DR + ccol;
                const v4u hv = *(const LAS v4u*)(lds + HS_OFF + tok * RSX + cgp * 16); const v4u gvj = gv[j];
                v4u o; o.x = pg8::cvt_pk_bf16(bflo(hv.x) * bflo(gvj.x), bfhi(hv.x) * bfhi(gvj.x)); o.y = pg8::cvt_pk_bf16(bflo(hv.y) * bflo(gvj.y), bfhi(hv.y) * bfhi(gvj.y));
                o.z = pg8::cvt_pk_bf16(bflo(hv.z) * bflo(gvj.z), bfhi(hv.z) * bfhi(gvj.z)); o.w = pg8::cvt_pk_bf16(bflo(hv.w) * bflo(gvj.w), bfhi(hv.w) * bfhi(gvj.w));
                *(v4u*)(Z + go) = o;
            }
        }
    }
#undef RNN_SEG
#undef RNN_LOADX
    if (fq == 0) A.out[(samp ? OFF_SHS : OFF_SHP) + (size_t)b * DR + c] = carry;
    __syncthreads();
}
}

constexpr int LDS_BYTES = 147456;
#ifndef PHMASK
#define PHMASK 0xFFF
#endif
#ifndef PHREP
#define PHREP 0
#endif
#define PH(k) for (int rep_ = 0; rep_ < (((PHMASK >> (k)) & 1) ? 1 + ((PHREP >> (k)) & 1) : 0); ++rep_)
__global__ void __launch_bounds__(512) yoco_fwd(Args A) {
    extern __shared__ __attribute__((aligned(16))) unsigned char lds_raw[];
    LAS unsigned char* lds = (LAS unsigned char*)lds_raw;
    cg::grid_group grid = cg::this_grid();
    unsigned char* ws = A.ws;
    const int G = gridDim.x, bx = blockIdx.x;
    bf16* H0 = (bf16*)(ws + WS_H0); bf16* H1 = (bf16*)(ws + WS_H1); bf16* H2 = (bf16*)(ws + WS_H2); bf16* H3 = (bf16*)(ws + WS_H3);
    bf16* ACT = (bf16*)(ws + WS_ACT);
    float* SSQ1 = (float*)(ws + WS_SSQ1); float* SSQ2 = (float*)(ws + WS_SSQ2); float* SSQ3 = (float*)(ws + WS_SSQ3); float* SSQ4 = (float*)(ws + WS_SSQ4);

    unsigned* barw = (unsigned*)ws;
    if (bx == 0) for (int i = threadIdx.x; i < XCD_BAR_WORDS; i += 512) barw[i] = 0u;
    volatile LAS unsigned* bst = (volatile LAS unsigned*)(lds + LDS_BYTES - 64);
    if (threadIdx.x < 2) bst[threadIdx.x] = 0u;
    __syncthreads();
    PH(0) p0_prologue(A, lds);
    grid.sync();
    const XcdBarrier xbar = xcd_barrier_post(barw, bst);
    PH(1) { pg8::Gemm g{H0, (const bf16*)(ws + WS_WIN), MROWS, 2 * DR, DM}; pg8::StaticOrder S; S.init(MROWS, 2 * DR, G, bx);
      pg8::EpiIn E{(bf16*)(ws + WS_GATE), (bf16*)(ws + WS_XR), (const float*)(ws + WS_RS0), A.out};
      pg8::gemm_phase<pg8::EpiIn, pg8::StaticOrder, true, true>(lds, g, S, E); }
    xcd_barrier(xbar);
    PH(2) for (int ch = bx; ch < 240; ch += G) rnn::chain(A, lds, ch);
    xcd_barrier(xbar);
    PH(3) { pg8::Gemm g{(const bf16*)(ws + WS_Z), (const bf16*)(ws + WS_WOUT), MROWS, DM, DR}; pg8::StaticOrder S; S.init(MROWS, DM, G, bx);
      pg8::EpiRes<false> E{H0, H1, nullptr, SSQ1};
      pg8::gemm_phase<pg8::EpiRes<false>, pg8::StaticOrder, true, true>(lds, g, S, E); }
    xcd_barrier(xbar);
    PH(4) { pg8::Gemm g{H1, (const bf16*)(ws + WS_WUP0), MROWS, DFF, DM}; pg8::StaticOrder S; S.init(MROWS, DFF, G, bx);
      pg8::EpiUp E{ACT, SSQ1};
      pg8::gemm_phase<pg8::EpiUp, pg8::StaticOrder, true, true>(lds, g, S, E); }
    xcd_barrier(xbar);
    PH(5) { pg8::Gemm g{ACT, (const bf16*)(ws + WS_WDN0), R_SAMP, DM, DFF}; pg8::StaticOrder S; S.init(R_SAMP, DM, G, bx);
      pg8::EpiRes<false> E{H1, H2, nullptr, SSQ2};
      pg8::gemm_phase<pg8::EpiRes<false>, pg8::StaticOrder, true, true>(lds, g, S, E); }
    xcd_barrier(xbar);
    PH(6) {
        if (bx < 8) {
            pg8::Gemm g{ACT, (const bf16*)(ws + WS_WDN0), MROWS, DM, DFF}; pg8::TailOrder S{R_SAMP / 256, DM / 256, 8, bx};
            pg8::EpiRes<false> E{H1, H2, nullptr, SSQ2};
            pg8::gemm_phase<pg8::EpiRes<false>, pg8::TailOrder, true, true>(lds, g, S, E);
        } else {
            static_assert(WS_VB - WS_KB == WS_QB - WS_VB, "K|V|Q spacing");
            pg8::Gemm g{H2, (const bf16*)(ws + WS_WKVQ), R_SAMP, 3 * DM, DM}; pg8::StaticOrder S; S.init(R_SAMP, 3 * DM, G - 8, bx - 8);
            pg8::EpiKVQ E{SSQ2, (bf16*)(ws + WS_KB), (bf16*)(ws + WS_CKB), (WS_VB - WS_KB) / 2, (WS_CVB - WS_CKB) / 2, A.out};
            pg8::gemm_phase<pg8::EpiKVQ, pg8::StaticOrder, true, true>(lds, g, S, E);
        }
    }
    xcd_barrier(xbar);
    PH(6) { pg8::Gemm g{H2, (const bf16*)(ws + WS_WKVQ), MROWS, 3 * DM, DM}; pg8::TailOrder S{R_SAMP / 256, 3 * DM / 256, 24, bx};
      pg8::EpiKVQ E{SSQ2, (bf16*)(ws + WS_KB), (bf16*)(ws + WS_CKB), (WS_VB - WS_KB) / 2, (WS_CVB - WS_CKB) / 2, A.out};
      pg8::gemm_phase<pg8::EpiKVQ, pg8::TailOrder, true, true>(lds, g, S, E); }
    xcd_barrier(xbar);
    PH(7) {
        const int lane = otid() & 63;
        const float d1 = wave_sum(A.in[I_LQ1][lane] * A.in[I_LK1][lane]), d2 = wave_sum(A.in[I_LQ2][lane] * A.in[I_LK2][lane]);
        const float lam = expf(d1) - expf(d2) + LAM_INIT;
        const bf16* KB = (const bf16*)(ws + WS_KB); const bf16* VB = (const bf16*)(ws + WS_VB); const bf16* QB = (const bf16*)(ws + WS_QB); bf16* OB = (bf16*)(ws + WS_OB);
        const float* lutg = (const float*)(ws + WS_LUT);
        const int vcu = (G % 8 == 0) ? (bx % 8) * (G / 8) + bx / 8 : bx;
        const bf16* CK = (const bf16*)(ws + WS_CKB); const bf16* CV = (const bf16*)(ws + WS_CVB);
#ifndef ATT_ABL
#define ATT_ABL -1
#endif
#pragma unroll 1
        for (int pass = 0; pass < (ATT_ABL >= 0 ? 2 : 1); ++pass)
#pragma unroll 1
        for (int i = 0;; ++i) {
            const int abl = pass ? ATT_ABL : 0;
            const int p = vcu + G * (i >> 1), k = i & 1;
            if (p >= 2048 + 64) break;
            const bf16 *Qh, *kme, *vme, *kma, *vma; bf16* Oh; int nqw, qpos0, nmain, h;
            if (p < 2048) {
                const int bh = p >> 4, s = p & 15, b = bh >> 3; h = bh & 7;
                const int qb = k ? 31 - s : s; const size_t r0 = (size_t)b * 4096 + 128 * qb;
                Qh = QB + r0 * DM + h * 128; Oh = OB + r0 * DM + h * 128; nqw = 4; qpos0 = 128 * qb; nmain = 4096;
                kme = KB + (size_t)R_META * DM + h * 128; vme = VB + (size_t)R_META * DM + h * 128;
                kma = KB + (size_t)b * 4096 * DM + h * 128; vma = VB + (size_t)b * 4096 * DM + h * 128;
            } else {
                if (k) continue;
                const int u = p - 2048, b = u >> 3; h = u & 7; const size_t r0 = (size_t)R_SAMP + 32 * b;
                Qh = QB + r0 * DM + h * 128; Oh = OB + r0 * DM + h * 128; nqw = 1; qpos0 = 1024; nmain = 1056;
                kme = CK + (size_t)b * 1072 * DM + h * 128; vme = CV + (size_t)b * 1072 * DM + h * 128;
                kma = kme + (size_t)16 * DM; vma = vme + (size_t)16 * DM;
            }
            if (pass) Oh = (bf16*)(ws + WS_H0) + (Oh - OB);
            att::attn_unit(lds, Qh, Oh, nqw, qpos0, kme, vme, kma, vma, nmain, lutg + h * 192, lutg[h * 192], lam, abl, nqw == 1);
        }
    }
    xcd_barrier(xbar);
    PH(8) { pg8::Gemm g{(const bf16*)(ws + WS_OB), (const bf16*)(ws + WS_WO), MROWS1, DM, DM}; pg8::StaticOrder S; S.init(MROWS1, DM, G, bx);
      pg8::EpiRes<false> E{H2, H3, nullptr, SSQ3};
      pg8::gemm_phase<pg8::EpiRes<false>, pg8::StaticOrder, true, true>(lds, g, S, E); }
    xcd_barrier(xbar);
    PH(9) { pg8::Gemm g{H3, (const bf16*)(ws + WS_WUP1), MROWS1, DFF, DM}; pg8::StaticOrder S; S.init(MROWS1, DFF, G, bx);
      pg8::EpiUp E{ACT, SSQ3};
      pg8::gemm_phase<pg8::EpiUp, pg8::StaticOrder, true, true>(lds, g, S, E); }
    xcd_barrier(xbar);
    PH(10) { pg8::Gemm g{ACT, (const bf16*)(ws + WS_WDN1), R_SAMP, DM, DFF}; pg8::StaticOrder S; S.init(R_SAMP, DM, G, bx);
      pg8::EpiRes<false> E{H3, H1, nullptr, SSQ4};
      pg8::gemm_phase<pg8::EpiRes<false>, pg8::StaticOrder, true, true>(lds, g, S, E); }
    xcd_barrier(xbar);
#define FINAL_NORM(ROW_BEGIN, ROW_END, WORKER, NWORKERS) do { \
        const int tid_ = otid(), lane = tid_ & 63, wave = __builtin_amdgcn_readfirstlane(tid_ >> 6); \
        const f32x4* gf = (const f32x4*)A.in[I_GF] + 2 * lane; \
        f32x4 gv[4]; \
        _Pragma("unroll") for (int j = 0; j < 2; ++j) { gv[2 * j] = gf[128 * j]; gv[2 * j + 1] = gf[128 * j + 1]; } \
        for (int row = (ROW_BEGIN) + (WORKER) * 8 + wave; row < (ROW_END); row += (NWORKERS) * 8) { \
            const float s = 1.0f / sqrtf(SSQ4[row] * (1.0f / DM) + EPS); \
            const v4u* hp = (const v4u*)(H1 + (size_t)row * DM) + lane;        \
            f32x4* y = (f32x4*)(A.out + OFF_Y + (size_t)row * DM) + 2 * lane; \
            _Pragma("unroll") for (int j = 0; j < 2; ++j) { \
                const v4u h = hp[64 * j]; \
                f32x4 v0 = {bflo(h.x), bfhi(h.x), bflo(h.y), bfhi(h.y)}, v1 = {bflo(h.z), bfhi(h.z), bflo(h.w), bfhi(h.w)}; \
                __builtin_nontemporal_store(v0 * s * gv[2 * j], &y[128 * j]); __builtin_nontemporal_store(v1 * s * gv[2 * j + 1], &y[128 * j + 1]); } \
        } } while (0)
    PH(11) {
        if (bx < 16) {
            pg8::Gemm g{ACT, (const bf16*)(ws + WS_WDN1), MROWS1, DM, 1024, DFF}; pg8::SplitKOrder S{R_SAMP / 256, DM / 256, 16, 1024 * 2, bx};
            pg8::EpiAcc E{(float*)(ws + WS_ACC), R_SAMP};
            pg8::gemm_phase<pg8::EpiAcc, pg8::SplitKOrder, true, true>(lds, g, S, E);
        } else FINAL_NORM(0, R_SAMP, bx - 16, G - 16);
    }
    xcd_barrier(xbar);
    PH(11) {
        const int tid_ = otid(), lane = tid_ & 63, wave = __builtin_amdgcn_readfirstlane(tid_ >> 6);
        const f32x4* gf = (const f32x4*)A.in[I_GF] + 2 * lane;
        for (int row = R_SAMP + bx * 8 + wave; row < MROWS1; row += G * 8) {
            const v4u* hp = (const v4u*)(H3 + (size_t)row * DM) + lane;
            const f32x4* ap = (const f32x4*)((const float*)(ws + WS_ACC) + (size_t)(row - R_SAMP) * DM) + 2 * lane;
            f32x4 v[4]; float sq = 0.f;
#pragma unroll
            for (int j = 0; j < 2; ++j) {
                const v4u h = hp[64 * j];
                v[2 * j] = ap[128 * j] + (f32x4){bflo(h.x), bfhi(h.x), bflo(h.y), bfhi(h.y)}; v[2 * j + 1] = ap[128 * j + 1] + (f32x4){bflo(h.z), bfhi(h.z), bflo(h.w), bfhi(h.w)};
            }
#pragma unroll
            for (int j = 0; j < 4; ++j) sq += (v[j].x * v[j].x + v[j].y * v[j].y) + (v[j].z * v[j].z + v[j].w * v[j].w);
            const float s = 1.0f / sqrtf(wave_sum(sq) * (1.0f / DM) + EPS);
            f32x4* y = (f32x4*)(A.out + OFF_Y + (size_t)row * DM) + 2 * lane;
#pragma unroll
            for (int j = 0; j < 2; ++j) { y[128 * j] = v[2 * j] * s * gf[128 * j]; y[128 * j + 1] = v[2 * j + 1] * s * gf[128 * j + 1]; }
        }
    }
#undef FINAL_NORM
}

extern "C" void kernel_launch(void* const* d_in, const int* in_sizes, int n_in, void* d_out, int out_size, void* d_ws, size_t ws_size, hipStream_t stream) {
    static int grid = 0;
    if (grid == 0) {
        if (n_in != 33 || ws_size < WS_END) { fprintf(stderr, "kernel_launch: unexpected inputs (n_in %d, ws %zu)\n", n_in, ws_size); grid = -1; return; }
        int dev = 0, cus = 0, per_cu = 0;
        (void)hipGetDevice(&dev);
        (void)hipDeviceGetAttribute(&cus, hipDeviceAttributeMultiprocessorCount, dev);
        (void)hipFuncSetAttribute((const void*)yoco_fwd, hipFuncAttributeMaxDynamicSharedMemorySize, LDS_BYTES);
        (void)hipOccupancyMaxActiveBlocksPerMultiprocessor(&per_cu, (const void*)yoco_fwd, 512, LDS_BYTES);
        if (per_cu < 1) per_cu = 1;
        grid = cus * per_cu;
        (void)hipGetLastError();
    }
    if (grid < 0) return;
    Args a{};
    for (int i = 0; i < 33; ++i) a.in[i] = (const float*)d_in[i];
    a.out = (float*)d_out; a.ws = (unsigned char*)d_ws;
    void* args[] = {&a};
    hipError_t e = hipLaunchCooperativeKernel((const void*)yoco_fwd, dim3(grid), dim3(512), args, LDS_BYTES, stream);
    if (e != hipSuccess) fprintf(stderr, "cooperative launch failed: %s (grid %d)\n", hipGetErrorString(e), grid);
}
```
